# Optimizing an MI355X kernel written in HIP

```python
import math
import jax, jax.numpy as jnp
from jax import lax
import numpy as np

D_MODEL = 2048
BATCH = 2
SEQ = 4096
DEPTH = 2

CTX_LEN = 256
GRID_W = 64
N_EVEN = (DEPTH + 1) // 2
N_ODD = DEPTH // 2
ALPHA = (2 * DEPTH) ** 0.25
BETA = (8 * DEPTH) ** -0.25
LN_EPS = 1e-6
FOURIER_WIDTH = D_MODEL // 2
FOURIER_GROUPS = 4
SGU_WIDTH = D_MODEL // 2
SGU_GROUPS = 4
SGU_CHUNK = 128
HEAD_DIM = 128
N_HEADS = D_MODEL // HEAD_DIM
N_KV_HEADS = N_HEADS // 4
Q_PER_KV = N_HEADS // N_KV_HEADS
WINDOW = 128
ATTN_BLOCK = WINDOW
ROPE_BASE = 10000.0
N_EXPERTS = 64
EXPERT_DIM = 512
SHARED_DIM = 512
TOP_K = 8
N_GROUPS = 8
TOPK_GROUPS = 4
ROUTED_SCALE = 2.5
MOE_BLOCK = 256

kernel_name = "hybrid_fourier_sgu_swa_moe_dit"

F32 = jnp.float32


def layer_norm(x, g, b):
    xf = x.astype(F32)
    mu = xf.mean(-1, keepdims=True)
    var = jnp.square(xf - mu).mean(-1, keepdims=True)
    return ((xf - mu) * lax.rsqrt(var + LN_EPS) * g.astype(F32) + b.astype(F32)).astype(x.dtype)


def rope_tables(row_ids, col_ids):
    quarter = HEAD_DIM // 4
    inv = ROPE_BASE ** (-jnp.arange(quarter, dtype=F32) / quarter)
    ang = jnp.stack([row_ids, col_ids], -1).astype(F32)[..., None] * inv
    return jnp.cos(ang), jnp.sin(ang)


def apply_rope_2d(x, cos, sin):
    b_, s_, h, _ = x.shape
    xf = x.astype(F32).reshape(b_, s_, h, 2, 2, HEAD_DIM // 4)
    x1, x2 = xf[..., 0, :], xf[..., 1, :]
    cs, sn = cos[None, :, None], sin[None, :, None]
    out = jnp.stack([x1 * cs - x2 * sn, x2 * cs + x1 * sn], axis=-2)
    return out.reshape(x.shape).astype(x.dtype)


def sink_softmax(s, sink):
    m = jnp.maximum(s.max(-1, keepdims=True), sink)
    p = jnp.exp(s - m)
    return p / (p.sum(-1, keepdims=True) + jnp.exp(sink - m))


def fourier_sgu_mixer(h, w_in, ln_g, ln_b, w_s, b_s, w_out):
    b_, l, _ = h.shape
    z = h @ w_in
    zf = z[..., :FOURIER_WIDTH].reshape(b_, l, FOURIER_GROUPS, -1)
    f = jnp.fft.fft2(zf.astype(F32), axes=(1, 3), norm="ortho").real.astype(h.dtype)
    u = jax.nn.gelu(z[..., FOURIER_WIDTH:FOURIER_WIDTH + SGU_WIDTH]).reshape(b_, l, SGU_GROUPS, -1)
    v = jax.nn.gelu(z[..., FOURIER_WIDTH + SGU_WIDTH:]).reshape(b_, l, SGU_GROUPS, -1)
    v = layer_norm(v, ln_g, ln_b)
    vc = v.reshape(b_, l // SGU_CHUNK, SGU_CHUNK, SGU_GROUPS, -1)
    vm = jnp.einsum('gpq,bnqgc->bnpgc', w_s, vc) + b_s.T[:, :, None]
    s = u * vm.reshape(u.shape)
    mixed = jnp.concatenate([f.reshape(b_, l, FOURIER_WIDTH), s.reshape(b_, l, SGU_WIDTH)], axis=-1)
    return mixed @ w_out


def project_qkv(h, w_qkv):
    b_, l, _ = h.shape
    z = h @ w_qkv
    nq, nk = N_HEADS * HEAD_DIM, N_KV_HEADS * HEAD_DIM
    q = z[..., :nq].reshape(b_, l, N_HEADS, HEAD_DIM)
    k = z[..., nq:nq + nk].reshape(b_, l, N_KV_HEADS, HEAD_DIM)
    v = z[..., nq + nk:].reshape(b_, l, N_KV_HEADS, HEAD_DIM)
    return q, k, v


def context_attention(qc, kc, vc, sink, w_out):
    b_, lc, _, _ = qc.shape
    qg = qc.reshape(b_, lc, N_KV_HEADS, Q_PER_KV, HEAD_DIM)
    s = jnp.einsum('bqhgd,bkhd->bhgqk', qg, kc, preferred_element_type=F32) * HEAD_DIM ** -0.5
    p = sink_softmax(s, sink.astype(F32).reshape(N_KV_HEADS, Q_PER_KV, 1, 1)).astype(vc.dtype)
    o = jnp.einsum('bhgqk,bkhd->bqhgd', p, vc).reshape(b_, lc, N_HEADS * HEAD_DIM)
    return o @ w_out


def latent_window_attention(q, k, v, kc, vc, sink, w_out):
    b_, s_, _, _ = q.shape
    nb = s_ // ATTN_BLOCK
    qb = q.reshape(b_, nb, ATTN_BLOCK, N_KV_HEADS, Q_PER_KV, HEAD_DIM)

    def band(t):
        tp = jnp.pad(t, ((0, 0), (ATTN_BLOCK, ATTN_BLOCK), (0, 0), (0, 0)))
        tp = tp.reshape(b_, nb + 2, ATTN_BLOCK, N_KV_HEADS, HEAD_DIM)
        return jnp.concatenate([tp[:, :-2], tp[:, 1:-1], tp[:, 2:]], axis=2)

    kw, vw = band(k), band(v)
    scale = HEAD_DIM ** -0.5
    s_loc = jnp.einsum('bnqhgd,bnkhd->bnhgqk', qb, kw, preferred_element_type=F32) * scale
    blk = jnp.arange(nb)[:, None, None] * ATTN_BLOCK
    qpos = blk + jnp.arange(ATTN_BLOCK)[None, :, None]
    kpos = blk - ATTN_BLOCK + jnp.arange(3 * ATTN_BLOCK)[None, None, :]
    valid = (jnp.abs(kpos - qpos) <= WINDOW) & (kpos >= 0) & (kpos < s_)
    s_loc = jnp.where(valid[None, :, None, None], s_loc, -jnp.inf)
    s_ctx = jnp.einsum('bnqhgd,bchd->bnhgqc', qb, kc, preferred_element_type=F32) * scale
    sink_b = sink.astype(F32).reshape(1, 1, N_KV_HEADS, Q_PER_KV, 1, 1)
    p = sink_softmax(jnp.concatenate([s_loc, s_ctx], axis=-1), sink_b).astype(v.dtype)
    nk = 3 * ATTN_BLOCK
    o = (jnp.einsum('bnhgqk,bnkhd->bnqhgd', p[..., :nk], vw)
         + jnp.einsum('bnhgqc,bchd->bnqhgd', p[..., nk:], vc))
    return o.reshape(b_, s_, N_HEADS * HEAD_DIM) @ w_out


def moe_ffn(h, router_w, router_bias, w_gate, w_up, w_down, ws_gate, ws_up, ws_down):
    t, d = h.shape
    scores = jax.nn.sigmoid(jnp.matmul(h, router_w, preferred_element_type=F32))
    biased = scores + router_bias.astype(F32)
    group_score = lax.top_k(biased.reshape(t, N_GROUPS, -1), 2)[0].sum(-1)
    _, gidx = lax.top_k(group_score, TOPK_GROUPS)
    gmask = jax.nn.one_hot(gidx, N_GROUPS, dtype=F32).sum(1)
    emask = jnp.repeat(gmask, N_EXPERTS // N_GROUPS, axis=1) > 0
    _, eidx = lax.top_k(jnp.where(emask, biased, -jnp.inf), TOP_K)
    wts = jnp.take_along_axis(scores, eidx, axis=1)
    wts = wts / wts.sum(-1, keepdims=True) * ROUTED_SCALE
    n = t * TOP_K
    flat_e = eidx.reshape(n).astype(jnp.int32)
    flat_t = jnp.repeat(jnp.arange(t, dtype=jnp.int32), TOP_K)
    flat_w = wts.reshape(n)
    order = jnp.argsort(flat_e)
    se = flat_e[order]
    counts = jnp.bincount(flat_e, length=N_EXPERTS)
    starts = jnp.cumsum(counts) - counts
    rank = jnp.arange(n, dtype=jnp.int32) - starts[se]
    padded = (counts + MOE_BLOCK - 1) // MOE_BLOCK * MOE_BLOCK
    pends = jnp.cumsum(padded)
    dest = (pends - padded)[se] + rank
    nblk = (n + N_EXPERTS * (MOE_BLOCK - 1) + MOE_BLOCK - 1) // MOE_BLOCK
    slots = nblk * MOE_BLOCK
    buf_t = jnp.zeros((slots,), jnp.int32).at[dest].set(flat_t[order])
    buf_w = jnp.zeros((slots,), F32).at[dest].set(flat_w[order])
    blk_e = jnp.minimum(jnp.searchsorted(pends, jnp.arange(nblk) * MOE_BLOCK, side='right'), N_EXPERTS - 1)

    def expert_block(args):
        tok, wt, e = args
        xb = h[tok]
        a = jax.nn.silu(xb @ w_gate[e]) * (xb @ w_up[e])
        return (a @ w_down[e]) * wt[:, None].astype(h.dtype)

    y = lax.map(expert_block, (buf_t.reshape(nblk, MOE_BLOCK), buf_w.reshape(nblk, MOE_BLOCK), blk_e))
    routed = jnp.zeros_like(h).at[buf_t].add(y.reshape(slots, d))
    shared = (jax.nn.silu(h @ ws_gate) * (h @ ws_up)) @ ws_down
    return routed + shared


def setup_inputs(seed: int = 0) -> dict:
    key = jax.random.key(seed)
    ks = jax.random.split(key, 32)

    def nrm(k, shape, scale):
        return jax.random.normal(k, shape, F32) * scale

    D = D_MODEL
    mix_in = FOURIER_WIDTH + 2 * SGU_WIDTH
    n_qkv = (N_HEADS + 2 * N_KV_HEADS) * HEAD_DIM
    v_cols = jnp.where(jnp.arange(n_qkv) >= (N_HEADS + N_KV_HEADS) * HEAD_DIM, BETA, 1.0).astype(F32)
    sgu_c = SGU_WIDTH // SGU_GROUPS
    return {
        "x": nrm(ks[0], (BATCH, SEQ, D), 1.0),
        "c": nrm(ks[1], (BATCH, D), 1.0),
        "ctx": nrm(ks[2], (BATCH, CTX_LEN, D), 1.0),
        "c_ctx": nrm(ks[3], (D,), 1.0),
        "ada_w": nrm(ks[4], (DEPTH, D, 6 * D), 0.5 * D ** -0.5),
        "ada_b": nrm(ks[5], (DEPTH, 6 * D), 0.02),
        "ln_mix_g": 1.0 + nrm(ks[6], (DEPTH, D), 0.02),
        "ln_mix_b": nrm(ks[7], (DEPTH, D), 0.02),
        "ln_ffn_g": 1.0 + nrm(ks[8], (DEPTH, D), 0.02),
        "ln_ffn_b": nrm(ks[9], (DEPTH, D), 0.02),
        "mix_w_in": nrm(ks[10], (N_EVEN, D, mix_in), D ** -0.5),
        "sgu_ln_g": 1.0 + nrm(ks[11], (N_EVEN, SGU_GROUPS, sgu_c), 0.02),
        "sgu_ln_b": nrm(ks[12], (N_EVEN, SGU_GROUPS, sgu_c), 0.02),
        "sgu_w_s": nrm(ks[13], (N_EVEN, SGU_GROUPS, SGU_CHUNK, SGU_CHUNK), SGU_CHUNK ** -0.5),
        "sgu_b_s": 1.0 + nrm(ks[14], (N_EVEN, SGU_GROUPS, SGU_CHUNK), 0.02),
        "mix_w_out": nrm(ks[15], (N_EVEN, FOURIER_WIDTH + SGU_WIDTH, D), BETA * (FOURIER_WIDTH + SGU_WIDTH) ** -0.5),
        "attn_w_qkv": nrm(ks[16], (N_ODD, D, n_qkv), D ** -0.5) * v_cols,
        "attn_sink": nrm(ks[17], (N_ODD, N_HEADS), 0.5),
        "attn_w_out": nrm(ks[18], (N_ODD, N_HEADS * HEAD_DIM, D), BETA * (N_HEADS * HEAD_DIM) ** -0.5),
        "router_w": nrm(ks[19], (DEPTH, D, N_EXPERTS), D ** -0.5),
        "router_bias": nrm(ks[20], (DEPTH, N_EXPERTS), 0.01),
        "moe_w_gate": nrm(ks[21], (DEPTH, N_EXPERTS, D, EXPERT_DIM), D ** -0.5),
        "moe_w_up": nrm(ks[22], (DEPTH, N_EXPERTS, D, EXPERT_DIM), D ** -0.5),
        "moe_w_down": nrm(ks[23], (DEPTH, N_EXPERTS, EXPERT_DIM, D), BETA * EXPERT_DIM ** -0.5),
        "shared_w_gate": nrm(ks[24], (DEPTH, D, SHARED_DIM), D ** -0.5),
        "shared_w_up": nrm(ks[25], (DEPTH, D, SHARED_DIM), D ** -0.5),
        "shared_w_down": nrm(ks[26], (DEPTH, SHARED_DIM, D), BETA * SHARED_DIM ** -0.5),
    }


def reference(x, c, ctx, c_ctx, ada_w, ada_b, ln_mix_g, ln_mix_b, ln_ffn_g, ln_ffn_b,
              mix_w_in, sgu_ln_g, sgu_ln_b, sgu_w_s, sgu_b_s, mix_w_out,
              attn_w_qkv, attn_sink, attn_w_out, router_w, router_bias,
              moe_w_gate, moe_w_up, moe_w_down, shared_w_gate, shared_w_up, shared_w_down):
    b_, s_, d = x.shape
    lc = ctx.shape[1]
    rows = s_ // GRID_W
    row_ids = jnp.broadcast_to(jnp.arange(rows, dtype=jnp.int32)[:, None], (rows, GRID_W)).reshape(-1)
    col_ids = jnp.broadcast_to(jnp.arange(GRID_W, dtype=jnp.int32)[None, :], (rows, GRID_W)).reshape(-1)
    cos, sin = rope_tables(row_ids, col_ids)
    silu_c = jax.nn.silu(c)
    silu_cc = jax.nn.silu(c_ctx)
    lat, cx = x, ctx
    for i in range(DEPTH):
        last = i == DEPTH - 1
        j = i // 2
        mod_l = (silu_c @ ada_w[i] + ada_b[i])[:, None, :]
        mod_c = (silu_cc @ ada_w[i] + ada_b[i])[None, None, :]
        sh1, sc1, g1, sh2, sc2, g2 = jnp.split(mod_l, 6, axis=-1)
        csh1, csc1, cg1, csh2, csc2, cg2 = jnp.split(mod_c, 6, axis=-1)
        hl = lat * (1.0 + sc1) + sh1
        hc = cx * (1.0 + csc1) + csh1
        if i % 2 == 0:
            mix_args = (mix_w_in[j], sgu_ln_g[j], sgu_ln_b[j], sgu_w_s[j], sgu_b_s[j], mix_w_out[j])
            ol = fourier_sgu_mixer(hl, *mix_args)
            if not last:
                oc = fourier_sgu_mixer(hc, *mix_args)
        else:
            q, k, v = project_qkv(hl, attn_w_qkv[j])
            q = apply_rope_2d(q, cos, sin)
            k = apply_rope_2d(k, cos, sin)
            qc, kc, vc = project_qkv(hc, attn_w_qkv[j])
            ol = latent_window_attention(q, k, v, kc, vc, attn_sink[j], attn_w_out[j])
            if not last:
                oc = context_attention(qc, kc, vc, attn_sink[j], attn_w_out[j])
        lat = layer_norm(ALPHA * lat + g1 * ol, ln_mix_g[i], ln_mix_b[i])
        if not last:
            cx = layer_norm(ALPHA * cx + cg1 * oc, ln_mix_g[i], ln_mix_b[i])
        hl = (lat * (1.0 + sc2) + sh2).reshape(b_ * s_, d)
        if last:
            tokens = hl
        else:
            hc = (cx * (1.0 + csc2) + csh2).reshape(b_ * lc, d)
            tokens = jnp.concatenate([hc, hl], axis=0)
        f = moe_ffn(tokens, router_w[i], router_bias[i], moe_w_gate[i], moe_w_up[i], moe_w_down[i],
                    shared_w_gate[i], shared_w_up[i], shared_w_down[i])
        fl = f[f.shape[0] - b_ * s_:].reshape(b_, s_, d)
        lat = layer_norm(ALPHA * lat + g2 * fl, ln_ffn_g[i], ln_ffn_b[i])
        if not last:
            fc = f[:b_ * lc].reshape(b_, lc, d)
            cx = layer_norm(ALPHA * cx + cg2 * fc, ln_ffn_g[i], ln_ffn_b[i])
    return lat
```

```cpp
#include <hip/hip_runtime.h>
#include <cstdio>
#include <cstdint>

#ifndef MK_PER_PHASE
#define MK_PER_PHASE 0
#endif

#define GAS __attribute__((address_space(1)))
#define LAS __attribute__((address_space(3)))
typedef unsigned short bf16_t;
typedef short bf16x8 __attribute__((ext_vector_type(8)));
typedef float f32x4 __attribute__((ext_vector_type(4)));
typedef float f32x2 __attribute__((ext_vector_type(2)));
typedef unsigned u32x4 __attribute__((ext_vector_type(4)));
typedef unsigned u32x2 __attribute__((ext_vector_type(2)));

constexpr int D = 2048, SEQ = 4096, CTXL = 256, NBATCH = 2;
constexpr int TC = NBATCH * CTXL;
constexpr int TL = NBATCH * SEQ;
constexpr int T0 = TC + TL;
constexpr int NEXP = 64, EDIM = 512, TOPK = 8;
constexpr int NE1 = NEXP + 1;
constexpr int SLOTS = 98304;
constexpr float ALPHA = 1.4142135623730951f;
constexpr float LN_EPS = 1e-6f;
constexpr float QSCALE = 0.08838834764831845f * 1.4426950408889634f;

constexpr size_t MiB = 1u << 20;
constexpr size_t WS_CTL = 0, CTL_ZERO_BYTES = 32 * 1024;
constexpr size_t WS_MOD = 1 * MiB;
constexpr size_t WS_ROPE = 1 * MiB + 512 * 1024;
constexpr size_t WS_WCT = 2 * MiB;
constexpr size_t WS_T256 = 2 * MiB + 256 * 1024;
constexpr size_t WS_RWH = 2 * MiB + 512 * 1024;
constexpr size_t WS_SELE = 3 * MiB;
constexpr size_t WS_SELW = 3 * MiB + 512 * 1024;
constexpr size_t WS_HIST = 4 * MiB;
constexpr size_t WS_EXPT = 4 * MiB + 128 * 1024;
constexpr size_t WS_SLOTTOK = 4 * MiB + 256 * 1024;
constexpr size_t WS_TOKSLOT = 5 * MiB;
constexpr size_t WS_RWL = 6 * MiB;
constexpr size_t WS_WIN = 8 * MiB;
constexpr size_t WS_WOUT = 20 * MiB;
constexpr size_t WS_WQK = 28 * MiB;
constexpr size_t WS_WV = 38 * MiB;
constexpr size_t WS_WAO = 40 * MiB;
constexpr size_t WS_WGU = 48 * MiB;
constexpr size_t WGU_E = (size_t)1024 * 2048 * 2, WGU_L = 65 * WGU_E;
constexpr size_t WS_WD = WS_WGU + 2 * WGU_L;
constexpr size_t WD_E = (size_t)2048 * 512 * 2, WD_L = 65 * WD_E;
constexpr size_t WGU8_E = (size_t)1024 * 2048, WGU8_L = 65 * WGU8_E;
constexpr size_t WD8_E = (size_t)2048 * 512, WD8_L = 65 * WD8_E;
constexpr size_t WS_X = 832 * MiB;
constexpr size_t WS_A0 = 900 * MiB;
constexpr size_t WS_Z = 934 * MiB;
constexpr size_t WS_YTL = 985 * MiB;
constexpr size_t WS_YTC = 1017 * MiB;
constexpr size_t WS_GT = 1019 * MiB;
constexpr size_t WS_MIX = 1051 * MiB;
constexpr size_t WS_ACT = 1085 * MiB;
constexpr size_t WS_YS = 1181 * MiB;
constexpr size_t WS_END = 1565 * MiB;
static_assert(WS_WD + 2 * WD_L <= WS_X && WS_YS + (size_t)SLOTS * 2048 * 2 <= WS_END, "ws map");
constexpr int CW_BAR = 4096;
static_assert((CW_BAR + 3456) * 4 <= (int)CTL_ZERO_BYTES, "barrier words inside the per-call memset");

constexpr int RING_BYTES = 131072;
constexpr int MISC_OFF = 145408;
constexpr int LDS_BYTES = 147456;
constexpr int NWAVES = 8, NTHREADS = 512;

#define LDS_WAIT() asm volatile("s_waitcnt lgkmcnt(0)" ::: "memory")
#define VM_WAIT() asm volatile("s_waitcnt vmcnt(0)" ::: "memory")
__device__ __forceinline__ unsigned f2bf(float f) { unsigned u = __builtin_bit_cast(unsigned, f); return (u + 0x7fffu + ((u >> 16) & 1u)) >> 16; }
__device__ __forceinline__ unsigned pk2(float lo, float hi) { return f2bf(lo) | (f2bf(hi) << 16); }
__device__ __forceinline__ float bf2f(unsigned short b) { return __builtin_bit_cast(float, ((unsigned)b) << 16); }
__device__ __forceinline__ float bflo(unsigned w) { return __builtin_bit_cast(float, w << 16); }
__device__ __forceinline__ float bfhi(unsigned w) { return __builtin_bit_cast(float, w & 0xffff0000u); }
__device__ __forceinline__ float wave_sum(float v) {
#pragma unroll
    for (int o = 1; o < 64; o <<= 1) v += __shfl_xor(v, o);
    return v;
}
__device__ __forceinline__ float gelu_tanh(float x) { const float u = 0.7978845608028654f * (x + 0.044715f * x * x * x); return x * __builtin_amdgcn_rcpf(1.0f + __expf(-2.0f * u)); }
__device__ __forceinline__ float sat8(float x) { return __builtin_amdgcn_fmed3f(x, -448.0f, 448.0f); }
__device__ __forceinline__ unsigned pk4_fp8(float a, float b, float c, float d) { int w = 0; w = __builtin_amdgcn_cvt_pk_fp8_f32(sat8(a), sat8(b), w, false); w = __builtin_amdgcn_cvt_pk_fp8_f32(sat8(c), sat8(d), w, true); return (unsigned)w; }
__device__ __forceinline__ f32x4 up4_fp8(unsigned w) { const f32x2 lo = __builtin_amdgcn_cvt_pk_f32_fp8((int)w, false), hi = __builtin_amdgcn_cvt_pk_f32_fp8((int)w, true); return (f32x4){lo[0], lo[1], hi[0], hi[1]}; }
__device__ __forceinline__ float silu_f(float x) { return x * __builtin_amdgcn_rcpf(1.0f + __expf(-x)); }

#define XB_TMO      128
#define XB_XCNT(j)  (256  + 64 * (j))
#define XB_XSUB(j)  (1280 + 64 * (j))
#define XB_XGEN(j)  (2304 + 64 * (j))
#define XB_TOP      3328
#define XB_TOPGEN   3392
#define XCD_BAR_WORDS 3456
#define XB_SPIN_CAP (1u << 18)
__device__ __forceinline__ unsigned xb_ld(unsigned* p)              { return __hip_atomic_load(p, __ATOMIC_RELAXED, __HIP_MEMORY_SCOPE_AGENT); }
__device__ __forceinline__ unsigned xb_add(unsigned* p, unsigned v) { return __hip_atomic_fetch_add(p, v, __ATOMIC_RELAXED, __HIP_MEMORY_SCOPE_AGENT); }
__device__ __forceinline__ unsigned xb_xcc_id() { return (unsigned)__builtin_amdgcn_s_getreg((3 << 11) | 20) & 0xFu; }
#define XB_SPIN(cond, bar) do { unsigned _sp = 0; while (cond) { __builtin_amdgcn_s_sleep(1); \
    if ((++_sp & 255u) == 0u) { if (xb_ld(&(bar)[XB_TMO])) break; if (_sp > XB_SPIN_CAP) { atomicAdd(&(bar)[XB_TMO], 1u); break; } } } } while (0)
struct XcdBarrier { unsigned* bar; unsigned x; volatile LAS unsigned* st; };
__device__ __forceinline__ XcdBarrier xcd_barrier_post(unsigned* bar, volatile LAS unsigned* st) {
    XcdBarrier b; b.bar = bar; b.x = xb_xcc_id(); b.st = st;
    if (threadIdx.x == 0) (void)xb_add(&bar[XB_XCNT(b.x)], 1u);
    return b;
}
__device__ __forceinline__ void xcd_barrier_complete(unsigned* bar, unsigned x, unsigned& nloc, unsigned& nx) {
    const unsigned G = gridDim.x * gridDim.y * gridDim.z;
    unsigned sum, cnt, mine, sp = 0u;
    for (;;) {
        sum = 0u; cnt = 0u; mine = 0u;
#pragma unroll
        for (unsigned j = 0; j < 16; ++j) { const unsigned c = xb_ld(&bar[XB_XCNT(j)]); sum += c; cnt += (c > 0u) ? 1u : 0u; mine = (j == x) ? c : mine; }
        if (sum == G) break;
        __builtin_amdgcn_s_sleep(1);
        if ((++sp & 255u) == 0u) { if (xb_ld(&bar[XB_TMO])) break; if (sp > XB_SPIN_CAP) { atomicAdd(&bar[XB_TMO], 1u); break; } }
    }
    nloc = mine > 0u ? mine : 1u; nx = cnt > 0u ? cnt : 1u;
}
__device__ __forceinline__ void xcd_barrier(const XcdBarrier& b) {
    asm volatile("s_waitcnt vmcnt(0)" ::: "memory");
    __syncthreads();
    if (threadIdx.x == 0) {
        unsigned* bar = b.bar;
        __builtin_amdgcn_s_waitcnt(0);
        unsigned nloc = b.st[0], nx = b.st[1];
        if (nloc == 0u) { xcd_barrier_complete(bar, b.x, nloc, nx); b.st[0] = nloc; b.st[1] = nx; }
        const unsigned old = xb_add(&bar[XB_XSUB(b.x)], 1u);
        const unsigned gen = old / nloc;
        if (old + 1u == (gen + 1u) * nloc) {
            __builtin_amdgcn_fence(__ATOMIC_RELEASE, "agent");
            asm volatile("s_waitcnt vmcnt(0)" ::: "memory");
            const unsigned og = xb_add(&bar[XB_TOP], 1u);
            const unsigned tg = og / nx;
            if (og + 1u == (tg + 1u) * nx) xb_add(&bar[XB_TOPGEN], 1u);
            else XB_SPIN(xb_ld(&bar[XB_TOPGEN]) == tg, bar);
            __builtin_amdgcn_fence(__ATOMIC_ACQUIRE, "agent");
            xb_add(&bar[XB_XGEN(b.x)], 1u);
            asm volatile("s_waitcnt vmcnt(0)" ::: "memory");
        } else {
            XB_SPIN(xb_ld(&bar[XB_XGEN(b.x)]) == gen, bar);
            __builtin_amdgcn_fence(__ATOMIC_ACQUIRE, "agent");
            asm volatile("s_waitcnt vmcnt(0)" ::: "memory");
        }
    }
    __syncthreads();
}

namespace pg8 {
constexpr int BM = 256, BK = 64, HALF = 128, HTB = HALF * BK * 2, NXCD = 8, WGM = 8;
__host__ __device__ __forceinline__ int lds_byte(int r, int c) { const int st = (r >> 4) * 2 + (c >> 5), rr = r & 15, cc = c & 31, ob = rr * 64 + cc * 2; return st * 1024 + (ob ^ (((ob >> 9) & 1) << 5)); }
__host__ __device__ __forceinline__ void stage_rc(int b, int& R, int& C) { const int st = b / 1024, sb = b % 1024, swz = sb ^ (((sb >> 9) & 1) << 5); R = (st >> 1) * 16 + swz / 64; C = (st & 1) * 32 + (swz % 64) / 2; }
__host__ __device__ __forceinline__ int perm32(int rho) { const int n = rho >> 4, i = rho & 15; return 8 * (i >> 2) + 4 * n + (i & 3); }
__device__ __forceinline__ unsigned cvt_pk_bf16(float lo, float hi) { unsigned r; asm volatile("v_cvt_pk_bf16_f32 %0, %1, %2" : "=v"(r) : "v"(lo), "v"(hi)); return r; }

struct Unit { const char* a; const char* b; int i0, i1, i2, i3; };

__device__ __forceinline__ void tile_order(int L, int nM, int nN, int& pm, int& pn) {
    const int nwg = nM * nN; int wgid = L;
    { const int q = nwg / NXCD, r = nwg % NXCD, xcd = wgid % NXCD, off = wgid / NXCD; wgid = (xcd < r ? xcd * (q + 1) : r * (q + 1) + (xcd - r) * q) + off; }
    const int nig = WGM * nN, gid = wgid / nig, fm = gid * WGM, gsz = (nM - fm) < WGM ? (nM - fm) : WGM;
    pm = fm + ((wgid % nig) % gsz); pn = (wgid % nig) / gsz;
}

typedef int i32x4m __attribute__((ext_vector_type(4)));
typedef int i32x8m __attribute__((ext_vector_type(8)));
__device__ __forceinline__ i32x8m cat8(bf16x8 a, bf16x8 b) { return __builtin_shufflevector(__builtin_bit_cast(i32x4m, a), __builtin_bit_cast(i32x4m, b), 0, 1, 2, 3, 4, 5, 6, 7); }
template <class Epi, class Sched, bool ALIGN_EPI = true, bool F8 = false, int SCALE_B = 127>
__device__ __forceinline__ void gemm_phase(LAS unsigned char* lds, const int K, const int ldb, const Sched& S, const Epi& E) {
    const int tid = threadIdx.x, wid = __builtin_amdgcn_readfirstlane(tid >> 6), lane = tid & 63, wr = wid >> 2, wc = wid & 3, fr = lane & 15, fq = lane >> 4;
    const int nt = K / BK;
    int sR[2], sC[2]; unsigned voffB[2];
#pragma unroll
    for (int i = 0; i < 2; ++i) { stage_rc(tid * 16 + i * 8192, sR[i], sC[i]); const int Rb = Epi::PERM ? ((sR[i] & ~31) + perm32(sR[i] & 31)) : sR[i]; voffB[i] = (unsigned)(Rb * ldb + sC[i]) * 2u; }
    const size_t kstep = (size_t)(BK * 2);
    const size_t hstepB = (size_t)HALF * ldb * 2;
    const unsigned ldsw = (unsigned)wid * 1024u;
    const int aoff = lds_byte(wr * 64 + fr, fq * 8), boff = lds_byte(wc * 32 + fr, fq * 8);
#define PG8_SA(b, h) (((b) * 2 + (h)) * HTB)
#define PG8_SB(b, h) ((4 + (b) * 2 + (h)) * HTB)
#define PG8_STAGE2(bufoff, gbase, v0, v1) do { \
        __builtin_amdgcn_global_load_lds((const unsigned*)((const char*)(gbase) + (v0)), (LAS unsigned*)(lds + (bufoff) + ldsw), 16, 0, 0); \
        __builtin_amdgcn_global_load_lds((const unsigned*)((const char*)(gbase) + (v1)), (LAS unsigned*)(lds + (bufoff) + ldsw + 8192), 16, 0, 0); } while (0)
#define PG8_STAGEB(bufoff, gbase) PG8_STAGE2(bufoff, gbase, voffB[0], voffB[1])
#define PG8_LDA(dst, b, h) do { _Pragma("unroll") for (int m = 0; m < 4; ++m) { if constexpr (F8) dst##8[m] = cat8(*(const LAS bf16x8*)(lds + PG8_SA(b, h) + aoff + m * 2048), *(const LAS bf16x8*)(lds + PG8_SA(b, h) + aoff + m * 2048 + 1024)); \
        else { _Pragma("unroll") for (int k = 0; k < 2; ++k) dst[m][k] = *(const LAS bf16x8*)(lds + PG8_SA(b, h) + aoff + m * 2048 + k * 1024); } } } while (0)
#define PG8_LDB(dst, b, h) do { _Pragma("unroll") for (int n = 0; n < 2; ++n) { if constexpr (F8) dst##8[n] = cat8(*(const LAS bf16x8*)(lds + PG8_SB(b, h) + boff + n * 2048), *(const LAS bf16x8*)(lds + PG8_SB(b, h) + boff + n * 2048 + 1024)); \
        else { _Pragma("unroll") for (int k = 0; k < 2; ++k) dst[n][k] = *(const LAS bf16x8*)(lds + PG8_SB(b, h) + boff + n * 2048 + k * 1024); } } } while (0)
#define PG8_MMA(ai, bj, At, Bt) do { __builtin_amdgcn_s_setprio(1); _Pragma("unroll") for (int m = 0; m < 4; ++m) _Pragma("unroll") for (int n = 0; n < 2; ++n) { \
        if constexpr (F8) asm volatile("v_mfma_scale_f32_16x16x128_f8f6f4 %0, %1, %2, %0, %3, %4 op_sel_hi:[0,0,0]" : "+v"(acc[ai][bj][m][n]) : "v"(Bt##8[n]), "v"(At##8[m]), "v"(scb), "v"(sca)); \
        else { _Pragma("unroll") for (int k = 0; k < 2; ++k) acc[ai][bj][m][n] = __builtin_amdgcn_mfma_f32_16x16x32_bf16(Bt[n][k], At[m][k], acc[ai][bj][m][n], 0, 0, 0); } } \
        __builtin_amdgcn_s_setprio(0); } while (0)
#define PG8_WAIT_V(n) asm volatile("s_waitcnt vmcnt(" #n ")" ::: "memory")
#define PG8_WAIT_L(n) asm volatile("s_waitcnt lgkmcnt(" #n ")" ::: "memory")
#define PG8_BAR __builtin_amdgcn_s_barrier()
#define PG8_SCHED __builtin_amdgcn_sched_barrier(0)
    Unit cur, nxt; int ui = 0;
    if (!S.next(0, cur)) return;
    f32x4 acc[2][2][4][2];
#pragma unroll
    for (int a = 0; a < 2; ++a)
#pragma unroll
        for (int b = 0; b < 2; ++b)
#pragma unroll
            for (int m = 0; m < 4; ++m)
#pragma unroll
                for (int n = 0; n < 2; ++n) acc[a][b][m][n] = (f32x4){0.f, 0.f, 0.f, 0.f};
    int scb = SCALE_B, sca = 127; asm volatile("" : "+v"(scb), "+v"(sca));
    bf16x8 At[4][2], B0[2][2], B1[2][2]; i32x8m At8[4], B08[2], B18[2];
    unsigned cv00 = S.aoff(cur, sR[0], sC[0]), cv01 = S.aoff(cur, sR[1], sC[1]), cv10 = S.aoff(cur, HALF + sR[0], sC[0]), cv11 = S.aoff(cur, HALF + sR[1], sC[1]);
    const char* cA = cur.a; const char* cB = cur.b;
    PG8_STAGEB(PG8_SB(0, 0), cB); PG8_STAGEB(PG8_SB(0, 1), cB + hstepB); PG8_STAGE2(PG8_SA(0, 0), cA, cv00, cv01); PG8_STAGE2(PG8_SA(0, 1), cA, cv10, cv11);
    if (wr == 1) PG8_BAR;
    PG8_WAIT_V(2); PG8_BAR;
    PG8_STAGEB(PG8_SB(1, 0), cB + kstep); PG8_STAGE2(PG8_SA(1, 0), cA + kstep, cv00, cv01); PG8_STAGEB(PG8_SB(1, 1), cB + hstepB + kstep);
    PG8_WAIT_V(6); PG8_BAR;
    for (;;) {
        const bool has_next = S.next(ui + 1, nxt);
        const char* nA = has_next ? nxt.a : cA; const char* nB = has_next ? nxt.b : cB;
        unsigned nv00 = cv00, nv01 = cv01, nv10 = cv10, nv11 = cv11;
        if (Sched::GATHER && has_next && nt < 6) { nv00 = S.aoff(nxt, sR[0], sC[0]); nv01 = S.aoff(nxt, sR[1], sC[1]); nv10 = S.aoff(nxt, HALF + sR[0], sC[0]); nv11 = S.aoff(nxt, HALF + sR[1], sC[1]); }
#pragma nounroll
        for (int t = 0; t < nt; t += 2) {
            const bool last = (t == nt - 2);
            const char* a1 = cA + (size_t)(t + 1) * kstep;
            const char* a2 = last ? nA : cA + (size_t)(t + 2) * kstep; const char* b2 = last ? nB : cB + (size_t)(t + 2) * kstep;
            const char* a3 = a2 + kstep; const char* b3 = b2 + kstep;
            const unsigned x00 = last ? nv00 : cv00, x01 = last ? nv01 : cv01, x10 = last ? nv10 : cv10, x11 = last ? nv11 : cv11;
            PG8_LDB(B0, 0, 0); PG8_LDB(B1, 0, 1); PG8_SCHED; PG8_LDA(At, 0, 0); PG8_STAGE2(PG8_SA(1, 1), a1, cv10, cv11);
            PG8_WAIT_V(8); PG8_WAIT_L(0); PG8_BAR; PG8_MMA(0, 0, At, B0); PG8_MMA(0, 1, At, B1); PG8_BAR; PG8_SCHED;
            PG8_LDA(At, 0, 1); PG8_STAGEB(PG8_SB(0, 0), b2); PG8_STAGEB(PG8_SB(0, 1), b2 + hstepB); PG8_STAGE2(PG8_SA(0, 0), a2, x00, x01);
            PG8_WAIT_V(8); PG8_WAIT_L(0); PG8_BAR; PG8_MMA(1, 0, At, B0); PG8_MMA(1, 1, At, B1); PG8_BAR; PG8_SCHED;
            PG8_LDB(B0, 1, 0); PG8_LDB(B1, 1, 1); PG8_SCHED; PG8_LDA(At, 1, 0); PG8_STAGE2(PG8_SA(0, 1), a2, x10, x11);
            PG8_WAIT_V(8); PG8_WAIT_L(0); PG8_BAR; PG8_MMA(0, 0, At, B0); PG8_MMA(0, 1, At, B1); PG8_BAR; PG8_SCHED;
            PG8_LDA(At, 1, 1); PG8_STAGEB(PG8_SB(1, 0), b3); PG8_STAGEB(PG8_SB(1, 1), b3 + hstepB); PG8_STAGE2(PG8_SA(1, 0), a3, x00, x01);
            PG8_WAIT_V(8); PG8_WAIT_L(0); PG8_BAR; PG8_MMA(1, 0, At, B0); PG8_MMA(1, 1, At, B1); PG8_BAR; PG8_SCHED;
            if (Sched::GATHER && has_next && nt >= 6 && t == nt - 6) { nv00 = S.aoff(nxt, sR[0], sC[0]); nv01 = S.aoff(nxt, sR[1], sC[1]); nv10 = S.aoff(nxt, HALF + sR[0], sC[0]); nv11 = S.aoff(nxt, HALF + sR[1], sC[1]); }
        }
        if constexpr (ALIGN_EPI) { if (wr == 0) PG8_BAR; }
        if constexpr (F8) asm volatile("s_nop 15\n\ts_nop 3" ::: "memory");
        E(acc, cur, wr, wc, fr, fq);
        if (!has_next) break;
#pragma unroll
        for (int a = 0; a < 2; ++a)
#pragma unroll
            for (int b = 0; b < 2; ++b)
#pragma unroll
                for (int m = 0; m < 4; ++m)
#pragma unroll
                    for (int n = 0; n < 2; ++n) acc[a][b][m][n] = (f32x4){0.f, 0.f, 0.f, 0.f};
        cur = nxt; cA = nA; cB = nB; cv00 = nv00; cv01 = nv01; cv10 = nv10; cv11 = nv11; ++ui;
        if constexpr (ALIGN_EPI) { if (wr == 1) PG8_BAR; }
    }
    PG8_WAIT_V(0);
    if constexpr (!ALIGN_EPI) { if (wr == 0) PG8_BAR; }
    PG8_BAR;
#undef PG8_SA
#undef PG8_SB
#undef PG8_STAGE2
#undef PG8_STAGEB
#undef PG8_LDA
#undef PG8_LDB
#undef PG8_MMA
#undef PG8_WAIT_V
#undef PG8_WAIT_L
#undef PG8_BAR
#undef PG8_SCHED
}
}
using pg8::Unit;
using pg8::cvt_pk_bf16;

struct Args { const float* in[27]; float* out; unsigned char* ws; int ph_lo, ph_hi; };
enum { I_X = 0, I_C, I_CTX, I_CCTX, I_ADAW, I_ADAB, I_LNMG, I_LNMB, I_LNFG, I_LNFB, I_WIN, I_SLNG, I_SLNB, I_SWS, I_SBS, I_WOUT, I_WQKV, I_SINK, I_WAO,
       I_RW, I_RB, I_MG, I_MU, I_MD, I_SG, I_SU, I_SD };

struct Frame {
    LAS unsigned char* lds;
    int tid, lane, wave, G, bid;
    unsigned char* ws;
};
__device__ __forceinline__ int modrow(int row) { return row < TC ? 2 : ((row - TC) >> 12); }
__device__ __forceinline__ const float* modp(const unsigned char* ws, int layer, int r, int chunk) { return (const float*)(ws + WS_MOD) + ((size_t)(layer * 3 + r) * 6 + chunk) * D; }

struct ConvJob { const float* src; bf16_t* dst; int K, N, mode; };
__device__ __forceinline__ int rope_pos(int d) { const int half = d >> 6, which = (d >> 5) & 1, f = d & 31; return 32 * (half * 2 + (f >> 4)) + 8 * ((f & 15) >> 2) + 4 * which + (f & 3); }
__device__ __forceinline__ void conv_item8(const float* __restrict__ src, int K, int N, int k0, int n0, unsigned char* dst, int mode, LAS float* scr, int lane) {
    f32x4 ld[16];
#pragma unroll
    for (int i = 0; i < 16; ++i) { const int kr = 8 * i + (lane >> 3), c4 = lane & 7; ld[i] = __builtin_nontemporal_load((const GAS f32x4*)(src + (size_t)(k0 + kr) * N + n0 + 4 * c4)); }
#pragma unroll
    for (int i = 0; i < 16; ++i) { const int kr = 8 * i + (lane >> 3), c4 = lane & 7;
        LAS float* s = scr + kr * 33 + 4 * c4; s[0] = ld[i][0]; s[1] = ld[i][1]; s[2] = ld[i][2]; s[3] = ld[i][3]; }
    LDS_WAIT(); asm volatile("" ::: "memory");
    const int c = lane & 15;
#pragma unroll
    for (int j = 0; j < 8; ++j) { const int nl = 4 * j + (lane >> 4), n = n0 + nl; const LAS float* s = scr + (8 * c) * 33 + nl;
        u32x2 o; o.x = pk4_fp8(32.f * s[0], 32.f * s[33], 32.f * s[2 * 33], 32.f * s[3 * 33]); o.y = pk4_fp8(32.f * s[4 * 33], 32.f * s[5 * 33], 32.f * s[6 * 33], 32.f * s[7 * 33]);
        const int row = mode == 0 ? n : (n >> 7) * 256 + (mode == 3 ? 128 : 0) + (n & 127);
        *(GAS u32x2*)(dst + (size_t)row * K + k0 + 8 * c) = o; }
    LDS_WAIT(); asm volatile("" ::: "memory");
}
__device__ __forceinline__ void conv_item(const float* __restrict__ src, int K, int N, int k0, int n0, bf16_t* dst, int mode, bf16_t* dst_v, LAS float* scr, int lane, bool f8 = false) {
    f32x4 ld[16];
#pragma unroll
    for (int i = 0; i < 16; ++i) { const int kr = 4 * i + (lane >> 4), c4 = lane & 15; ld[i] = __builtin_nontemporal_load((const GAS f32x4*)(src + (size_t)(k0 + kr) * N + n0 + 4 * c4)); }
#pragma unroll
    for (int i = 0; i < 16; ++i) { const int kr = 4 * i + (lane >> 4), c4 = lane & 15;
        LAS float* s = scr + kr * 65 + 4 * c4; s[0] = ld[i][0]; s[1] = ld[i][1]; s[2] = ld[i][2]; s[3] = ld[i][3]; }
    LDS_WAIT(); asm volatile("" ::: "memory");
    const int c = lane & 7;
#pragma unroll
    for (int j = 0; j < 8; ++j) { const int nl = 8 * j + (lane >> 3), n = n0 + nl; const LAS float* s = scr + (8 * c) * 65 + nl;
        if (f8) {
            u32x2 o; o.x = pk4_fp8(32.f * s[0], 32.f * s[65], 32.f * s[2 * 65], 32.f * s[3 * 65]); o.y = pk4_fp8(32.f * s[4 * 65], 32.f * s[5 * 65], 32.f * s[6 * 65], 32.f * s[7 * 65]);
            const int row = mode == 0 ? n : (n >> 7) * 256 + (mode == 3 ? 128 : 0) + (n & 127);
            *(GAS u32x2*)((unsigned char*)dst + (size_t)row * K + k0 + 8 * c) = o; continue; }
        u32x4 o; o.x = pk2(s[0], s[65]); o.y = pk2(s[2 * 65], s[3 * 65]); o.z = pk2(s[4 * 65], s[5 * 65]); o.w = pk2(s[6 * 65], s[7 * 65]);
        bf16_t* drow;
        if (mode == 0) drow = dst + (size_t)n * K;
        else if (mode == 1) { if (n < 2560) drow = dst + (size_t)((n & ~127) + rope_pos(n & 127)) * K; else drow = dst_v + (size_t)(n - 2560) * K; }
        else { const int ntile = n >> 7, r = n & 127; drow = dst + (size_t)(ntile * 256 + (mode == 3 ? 128 : 0) + r) * K; }
        *(GAS u32x4*)(drow + k0 + 8 * c) = o; }
    LDS_WAIT(); asm volatile("" ::: "memory");
}
namespace cv { constexpr int I_A = 32 * 48, I_B = 32 * 32, I_E = 256; constexpr int N0 = I_A, N1 = N0 + I_B, N2 = N1 + I_A, N3 = N2 + I_B, NG = N3 + 130 * I_E, NU = NG + 130 * I_E, ND = NU + 130 * I_E, HALFM = 65 * I_E; }
constexpr int CW_QHEAD = 2048;
static __device__ __forceinline__ void conv_impl(LAS unsigned char* lds, unsigned char* ws, const float* win, const float* wout, const float* wqkv, const float* wao, const float* mg, const float* mu, const float* md,
                                       const float* sg, const float* su, const float* sd, int it_lo, int it_hi, int gw, int NGW, unsigned* qhead, int quota) {
    using namespace cv;
    const int lane = threadIdx.x & 63, wave = threadIdx.x >> 6;
    LAS float* scr = (LAS float*)(lds + wave * 16896);
    int it0 = it_lo + gw; bool deferred = false;
    if (qhead) { deferred = true;
        if (quota >= 0) { unsigned d = 0u; if (lane == 0) d = __hip_atomic_fetch_add(qhead, (unsigned)quota, __ATOMIC_RELAXED, __HIP_MEMORY_SCOPE_AGENT);
            it0 = __builtin_amdgcn_readfirstlane((int)d); it_hi = it0 + quota; NGW = 1; }
        else { const unsigned h = __hip_atomic_load(qhead, __ATOMIC_RELAXED, __HIP_MEMORY_SCOPE_AGENT); it0 = (int)h + gw; }
        if (it_hi > 4 * HALFM) it_hi = 4 * HALFM; }
    for (;;) {
        if (it0 >= it_hi) break;
        int it = it0; it0 += NGW;
        if (deferred) it = it < HALFM ? NU + it : it < 2 * HALFM ? N3 + it : it < 3 * HALFM ? NG + it - HALFM : NU + it - 2 * HALFM;
        const float* src; bf16_t* dst; bf16_t* dstv = nullptr; int K, N, mode, r; bool f8 = false;
        if (it < N0) { r = it; src = win; dst = (bf16_t*)(ws + WS_WIN); K = 2048; N = 3072; mode = 0; }
        else if (it < N1) { r = it - N0; src = wout; dst = (bf16_t*)(ws + WS_WOUT); K = 2048; N = 2048; mode = 0; }
        else if (it < N2) { r = it - N1; src = wqkv; dst = (bf16_t*)(ws + WS_WQK); dstv = (bf16_t*)(ws + WS_WV); K = 2048; N = 3072; mode = 1; }
        else if (it < N3) { r = it - N2; src = wao; dst = (bf16_t*)(ws + WS_WAO); K = 2048; N = 2048; mode = 0; }
        else {
            int cls, q; if (it < NG) { cls = 0; q = it - N3; } else if (it < NU) { cls = 1; q = it - NG; } else { cls = 2; q = it - NU; }
            const int mat = q / I_E; r = q % I_E; const int layer = mat / 65, e = mat % 65;
            if (cls < 2) { K = 2048; N = 512; mode = 2 + cls;
                src = (e < 64) ? (cls == 0 ? mg : mu) + ((size_t)(layer * 64 + e)) * 2048 * 512 : (cls == 0 ? sg : su) + (size_t)layer * 2048 * 512;
                dst = (bf16_t*)(ws + WS_WGU + layer * WGU8_L + e * WGU8_E); f8 = true; }
            else { K = 512; N = 2048; mode = 0;
                src = (e < 64) ? md + ((size_t)(layer * 64 + e)) * 512 * 2048 : sd + (size_t)layer * 512 * 2048;
                dst = (bf16_t*)(ws + WS_WD + layer * WD8_L + e * WD8_E); f8 = true; }
        }
        if (f8) { const int nb = N / 32, kb = r / nb, nbi = r % nb; conv_item8(src, K, N, kb * 128, nbi * 32, (unsigned char*)dst, mode, scr, lane); }
        else { const int nb = N / 64, kb = r / nb, nbi = r % nb; conv_item(src, K, N, kb * 64, nbi * 64, dst, mode, dstv, scr, lane, false); }
    }
}
__device__ __forceinline__ void conv_range(const Frame& F, const Args& a, int it_lo, int it_hi) {
    conv_impl(F.lds, F.ws, a.in[I_WIN], a.in[I_WOUT], a.in[I_WQKV], a.in[I_WAO], a.in[I_MG], a.in[I_MU], a.in[I_MD], a.in[I_SG], a.in[I_SU], a.in[I_SD], it_lo, it_hi, F.bid * NWAVES + F.wave, F.G * NWAVES, nullptr, 0);
}
__device__ __forceinline__ void conv_pull(const Frame& F, const Args& a, int quota) {
    if (quota > 0) conv_impl(F.lds, F.ws, a.in[I_WIN], a.in[I_WOUT], a.in[I_WQKV], a.in[I_WAO], a.in[I_MG], a.in[I_MU], a.in[I_MD], a.in[I_SG], a.in[I_SU], a.in[I_SD], 0, 0, 0, 1, (unsigned*)(F.ws + WS_CTL) + CW_QHEAD, quota);
}
__device__ __forceinline__ void conv_cleanup(const Frame& F, const Args& a, int upto) {
    conv_impl(F.lds, F.ws, a.in[I_WIN], a.in[I_WOUT], a.in[I_WQKV], a.in[I_WAO], a.in[I_MG], a.in[I_MU], a.in[I_MD], a.in[I_SG], a.in[I_SU], a.in[I_SD], 0, upto, F.bid * NWAVES + F.wave, F.G * NWAVES, (unsigned*)(F.ws + WS_CTL) + CW_QHEAD, -1);
}
__device__ __forceinline__ void p0_mod(const Frame& F, const Args& a) {
    LAS float* sv = (LAS float*)F.lds;
    LAS float* red = (LAS float*)(F.lds + 32768);
    for (int i = F.tid; i < 3 * D; i += NTHREADS) { const int r = i / D, k = i % D; const float v = r < 2 ? a.in[I_C][r * D + k] : a.in[I_CCTX][k]; sv[i] = silu_f(v); }
    __syncthreads();
    float* mod = (float*)(F.ws + WS_MOD);
    for (int u = F.bid; u < 256; u += F.G) {
        const int layer = u >> 7, n0 = (u & 127) * 96;
        const float* W = a.in[I_ADAW] + (size_t)layer * D * 12288;
        const int kq = F.lane / 24, c4 = F.lane % 24; const bool act = F.lane < 48;
        f32x4 acc[3] = {{0.f, 0.f, 0.f, 0.f}, {0.f, 0.f, 0.f, 0.f}, {0.f, 0.f, 0.f, 0.f}};
        if (act) {
#pragma unroll 8
            for (int it = 0; it < 128; ++it) { const int k = F.wave * 256 + it * 2 + kq;
                const f32x4 w = __builtin_nontemporal_load((const GAS f32x4*)(W + (size_t)k * 12288 + n0 + 4 * c4));
#pragma unroll
                for (int r = 0; r < 3; ++r) acc[r] += w * sv[r * D + k]; } }
#pragma unroll
        for (int r = 0; r < 3; ++r)
#pragma unroll
            for (int j = 0; j < 4; ++j) { const float o = __shfl(acc[r][j], (F.lane + 24) & 63); if (F.lane < 24) red[(F.wave * 3 + r) * 96 + 4 * c4 + j] = acc[r][j] + o; }
        __syncthreads();
        if (F.tid < 288) { const int r = F.tid / 96, cidx = F.tid % 96; float s = 0.f;
#pragma unroll
            for (int w = 0; w < 8; ++w) s += red[(w * 3 + r) * 96 + cidx];
            mod[(size_t)(layer * 3 + r) * 12288 + n0 + cidx] = s + a.in[I_ADAB][layer * 12288 + n0 + cidx]; }
        __syncthreads();
    }
}
__device__ __forceinline__ void p0_tables(const Frame& F, const float* rwsrc) {
    bf16_t* wct = (bf16_t*)(F.ws + WS_WCT); bf16_t* t256 = (bf16_t*)(F.ws + WS_T256); f32x2* rope = (f32x2*)(F.ws + WS_ROPE);
    const int gt = F.bid * NTHREADS + F.tid, NGT = F.G * NTHREADS;
    for (int i = gt; i < 256 * 256; i += NGT) { const int m = i >> 8, c = i & 255, j = (m * c) & 255;
        const float cs = cospif((float)j * (1.0f / 128.0f)), sn = sinpif((float)j * (1.0f / 128.0f));
        wct[(2 * m) * 256 + c] = (bf16_t)f2bf(cs); wct[(2 * m + 1) * 256 + c] = (bf16_t)f2bf(-sn);
        t256[m * 512 + c] = (bf16_t)f2bf(cs); t256[m * 512 + 256 + c] = (bf16_t)f2bf(sn); }
    for (int i = gt; i < 2 * D * NEXP; i += NGT) { const int layer = i / (D * NEXP), k = (i / NEXP) % D, e = i % NEXP; const float w = rwsrc[i];
        const unsigned hi = f2bf(w); const float lo = w - __builtin_bit_cast(float, hi << 16);
        ((bf16_t*)(F.ws + WS_RWH))[(size_t)(layer * NEXP + e) * D + k] = (bf16_t)hi; ((bf16_t*)(F.ws + WS_RWL))[(size_t)(layer * NEXP + e) * D + k] = (bf16_t)f2bf(lo); }
    for (int i = gt; i < 64 * 32; i += NGT) { const int id = i >> 5, f = i & 31;
        const double inv = pow(10000.0, -(double)f / 32.0); const double ang = (double)id * (double)(float)inv;
        rope[i] = (f32x2){(float)cos(ang), (float)sin(ang)}; }
}

__device__ __forceinline__ void phase_modulate0(const Frame& F, const Args& a) {
    bf16_t* A0 = (bf16_t*)(F.ws + WS_A0);
    const int gw = F.bid * NWAVES + F.wave, NGW = F.G * NWAVES;
    for (int row = gw; row < T0; row += NGW) {
        const float* src = row < TC ? a.in[I_CTX] + (size_t)row * D : a.in[I_X] + (size_t)(row - TC) * D;
        const int r = modrow(row); const float* sh = modp(F.ws, 0, r, 0); const float* sc = modp(F.ws, 0, r, 1);
#pragma unroll
        for (int j = 0; j < 8; ++j) { const int c = 4 * F.lane + 256 * j;
            const f32x4 v = *(const GAS f32x4*)(src + c), s = *(const GAS f32x4*)(sc + c), h = *(const GAS f32x4*)(sh + c);
            const f32x4 o = v * (s + 1.0f) + h; u32x2 w; w.x = pk2(o[0], o[1]); w.y = pk2(o[2], o[3]);
            *(GAS u32x2*)(A0 + (size_t)row * D + c) = w; }
    }
}

__device__ __forceinline__ void phase_butterfly(const Frame& F) {
    LAS f32x2* tw = (LAS f32x2*)F.lds;
    for (int j = F.tid; j < 4096; j += NTHREADS) { const float x = (float)j * (1.0f / 2048.0f); tw[j] = (f32x2){cospif(x), sinpif(x)}; }
    __syncthreads();
    const bf16_t* Yt = (const bf16_t*)(F.ws + WS_YTL); bf16_t* Gt = (bf16_t*)(F.ws + WS_GT);
    for (int item = F.bid * NTHREADS + F.tid; item < 2 * 1024 * 64; item += F.G * NTHREADS) {
        const int lq = item & 63, n = (item >> 6) & 1023, b = item >> 16, l1 = 4 * lq;
        const bf16_t* yre = Yt + ((size_t)(b * 1024 + n) * 2 + 0) * 4096 + l1; const bf16_t* yim = yre + 4096;
        float are[16][4], aim[16][4];
#pragma unroll
        for (int l2 = 0; l2 < 16; ++l2) { const u32x2 p = *(const GAS u32x2*)(yre + 256 * l2), q = *(const GAS u32x2*)(yim + 256 * l2);
            are[l2][0] = bflo(p.x); are[l2][1] = bfhi(p.x); are[l2][2] = bflo(p.y); are[l2][3] = bfhi(p.y);
            aim[l2][0] = bflo(q.x); aim[l2][1] = bfhi(q.x); aim[l2][2] = bflo(q.y); aim[l2][3] = bfhi(q.y); }
        for (int r = 0; r < 16; ++r) {
            float sre[4] = {0.f, 0.f, 0.f, 0.f}, sim[4] = {0.f, 0.f, 0.f, 0.f};
#pragma unroll
            for (int l2 = 0; l2 < 16; ++l2) { const f32x2 cs = tw[((l2 * r) & 15) * 256];
#pragma unroll
                for (int e = 0; e < 4; ++e) { sre[e] += are[l2][e] * cs.x + aim[l2][e] * cs.y; sim[e] += aim[l2][e] * cs.x - are[l2][e] * cs.y; } }
            float gre[4], gim[4];
#pragma unroll
            for (int e = 0; e < 4; ++e) { const f32x2 cs = tw[((l1 + e) * r) & 4095]; gre[e] = sre[e] * cs.x + sim[e] * cs.y; gim[e] = sim[e] * cs.x - sre[e] * cs.y; }
            bf16_t* g = Gt + ((size_t)((b * 16 + r) * 1024 + n) * 2) * 256 + l1;
            u32x2 w; w.x = pk2(gre[0], gre[1]); w.y = pk2(gre[2], gre[3]); *(GAS u32x2*)g = w;
            w.x = pk2(gim[0], gim[1]); w.y = pk2(gim[2], gim[3]); *(GAS u32x2*)(g + 256) = w;
        }
    }
}

struct DenseSched {
    static constexpr bool GATHER = false;
    const char* A; const char* B; int lda, ldb, nM, nN, G, c;
    __device__ __forceinline__ bool next(int i, Unit& u) const { const int L = i * G + c; if (L >= nM * nN) return false; int pm, pn; pg8::tile_order(L, nM, nN, pm, pn);
        u.a = A + (size_t)pm * 256 * lda * 2; u.b = B + (size_t)pn * 256 * ldb * 2; u.i0 = pm; u.i1 = pn; u.i2 = 0; u.i3 = 0; return true; }
    __device__ __forceinline__ unsigned aoff(const Unit&, int R, int C) const { return (unsigned)(R * lda + C) * 2u; }
};
struct EpiWin { static constexpr bool PERM = true; bf16_t* Z;
    __device__ __forceinline__ void operator()(const f32x4 (&acc)[2][2][4][2], const Unit& u, int wr, int wc, int fr, int fq) const {
        const int row0 = u.i0 * 256 + wr * 64 + fr, col0 = u.i1 * 256 + wc * 32 + 8 * fq; const bool act = u.i1 >= 4;
#pragma unroll
        for (int ai = 0; ai < 2; ++ai)
#pragma unroll
            for (int m = 0; m < 4; ++m) { bf16_t* rowp = Z + (size_t)(row0 + ai * 128 + m * 16) * 3072 + col0;
#pragma unroll
                for (int bj = 0; bj < 2; ++bj) { f32x4 v0 = acc[ai][bj][m][0], v1 = acc[ai][bj][m][1];
                    if (act) {
#pragma unroll
                        for (int j = 0; j < 4; ++j) { v0[j] = gelu_tanh(v0[j]); v1[j] = gelu_tanh(v1[j]); } }
                    u32x4 w; w.x = cvt_pk_bf16(v0[0], v0[1]); w.y = cvt_pk_bf16(v0[2], v0[3]); w.z = cvt_pk_bf16(v1[0], v1[1]); w.w = cvt_pk_bf16(v1[2], v1[3]);
                    *(GAS u32x4*)(rowp + bj * 128) = w; } }
    }
};
struct EpiResid { static constexpr bool PERM = true; bf16_t* X; const float* rx; const float* rctx; const unsigned char* ws; int layer, rowbase;
    __device__ __forceinline__ void operator()(const f32x4 (&acc)[2][2][4][2], const Unit& u, int wr, int wc, int fr, int fq) const {
        const int row0 = rowbase + u.i0 * 256 + wr * 64 + fr, col0 = u.i1 * 256 + wc * 32 + 8 * fq;
        const float* g1 = modp(ws, layer, modrow(rowbase + u.i0 * 256), 2) + col0;
        f32x4 gv[2][2];
#pragma unroll
        for (int bj = 0; bj < 2; ++bj)
#pragma unroll
            for (int n = 0; n < 2; ++n) gv[bj][n] = *(const GAS f32x4*)(g1 + bj * 128 + n * 4);
#pragma unroll
        for (int ai = 0; ai < 2; ++ai)
#pragma unroll
            for (int m = 0; m < 4; ++m) { const int row = row0 + ai * 128 + m * 16; bf16_t* op = X + (size_t)row * D + col0;
#pragma unroll
                for (int bj = 0; bj < 2; ++bj) { f32x4 r0, r1;
                    if (layer == 0) { const float* rp = (row < TC ? rctx + (size_t)row * D : rx + (size_t)(row - TC) * D) + col0 + bj * 128; r0 = *(const GAS f32x4*)rp; r1 = *(const GAS f32x4*)(rp + 4); }
                    else { const u32x4 p = *(const GAS u32x4*)(op + bj * 128); r0 = (f32x4){bflo(p.x), bfhi(p.x), bflo(p.y), bfhi(p.y)}; r1 = (f32x4){bflo(p.z), bfhi(p.z), bflo(p.w), bfhi(p.w)}; }
                    const f32x4 v0 = r0 * ALPHA + gv[bj][0] * acc[ai][bj][m][0], v1 = r1 * ALPHA + gv[bj][1] * acc[ai][bj][m][1];
                    u32x4 w; w.x = cvt_pk_bf16(v0[0], v0[1]); w.y = cvt_pk_bf16(v0[2], v0[3]); w.z = cvt_pk_bf16(v1[0], v1[1]); w.w = cvt_pk_bf16(v1[2], v1[3]);
                    *(GAS u32x4*)(op + bj * 128) = w; } }
    }
};
struct EpiBf16G { static constexpr bool PERM = true; bf16_t* O0; bf16_t* O1; int ldc0, ldc1; float sc0, sc1;
    __device__ __forceinline__ void operator()(const f32x4 (&acc)[2][2][4][2], const Unit& u, int wr, int wc, int fr, int fq) const {
        bf16_t* O = u.i3 ? O1 : O0; const int ldc = u.i3 ? ldc1 : ldc0; const float sc = u.i3 ? sc1 : sc0; const int rs = u.i1;
        const int r0 = wr * 64 + fr, col0 = u.i2 + wc * 32 + 8 * fq;
#pragma unroll
        for (int ai = 0; ai < 2; ++ai)
#pragma unroll
            for (int m = 0; m < 4; ++m) { bf16_t* rowp = O + (size_t)(u.i0 + rs * (r0 + ai * 128 + m * 16)) * ldc + col0;
#pragma unroll
                for (int bj = 0; bj < 2; ++bj) { const f32x4 v0 = acc[ai][bj][m][0] * sc, v1 = acc[ai][bj][m][1] * sc;
                    u32x4 w; w.x = cvt_pk_bf16(v0[0], v0[1]); w.y = cvt_pk_bf16(v0[2], v0[3]); w.z = cvt_pk_bf16(v1[0], v1[1]); w.w = cvt_pk_bf16(v1[2], v1[3]);
                    *(GAS u32x4*)(rowp + bj * 128) = w; } }
    }
};
struct EpiYs8 { static constexpr bool PERM = true; unsigned char* YS;
    __device__ __forceinline__ void operator()(const f32x4 (&acc)[2][2][4][2], const Unit& u, int wr, int wc, int fr, int fq) const {
        const int r0 = wr * 64 + fr, col0 = u.i2 + wc * 32 + 8 * fq;
#pragma unroll
        for (int ai = 0; ai < 2; ++ai)
#pragma unroll
            for (int m = 0; m < 4; ++m) { unsigned char* rowp = YS + (size_t)(u.i0 + r0 + ai * 128 + m * 16) * D + col0;
#pragma unroll
                for (int bj = 0; bj < 2; ++bj) { const f32x4 v0 = acc[ai][bj][m][0] * 16.0f, v1 = acc[ai][bj][m][1] * 16.0f;
                    u32x2 w; w.x = pk4_fp8(v0[0], v0[1], v0[2], v0[3]); w.y = pk4_fp8(v1[0], v1[1], v1[2], v1[3]);
                    *(GAS u32x2*)(rowp + bj * 128) = w; } }
    }
};
struct Dft1Sched { static constexpr bool GATHER = false; const unsigned char* ws; int G, c;
    __device__ __forceinline__ bool next(int i, Unit& u) const { const int L = i * G + c; if (L >= 272) return false;
        int bg, mt, ntile, isctx; if (L < 256) { bg = L >> 5; mt = (L >> 4) & 1; ntile = L & 15; isctx = 0; } else { const int v = L - 256; bg = v >> 1; mt = v & 1; ntile = 0; isctx = 1; }
        const int b = bg >> 2, g = bg & 3, rowbase = isctx ? b * CTXL : TC + b * SEQ;
        u.a = (const char*)(ws + WS_WCT) + (size_t)mt * 256 * 256 * 2; u.b = (const char*)(ws + WS_Z) + ((size_t)(rowbase + ntile * 256) * 3072 + g * 256) * 2;
        u.i0 = bg * 512 + mt * 256; u.i1 = 1; u.i2 = ntile * 256; u.i3 = isctx; return true; }
    __device__ __forceinline__ unsigned aoff(const Unit&, int R, int C) const { return (unsigned)(R * 256 + C) * 2u; }
};
struct Dft2Sched { static constexpr bool GATHER = false; const unsigned char* ws; int G, c;
    __device__ __forceinline__ bool next(int i, Unit& u) const { const int L = i * G + c; if (L >= 136) return false;
        u.a = (const char*)(ws + WS_T256); u.i2 = (L & 3) * 256;
        if (L < 128) { const int b = L >> 6, r = (L >> 2) & 15, nt = L & 3; u.b = (const char*)(ws + WS_GT) + ((size_t)((b * 16 + r) * 1024 + nt * 256) * 512) * 2; u.i0 = TC + b * SEQ + r; u.i1 = 16; u.i3 = 0; }
        else { const int v = L - 128, b = v >> 2, nt = v & 3; u.b = (const char*)(ws + WS_YTC) + ((size_t)(b * 1024 + nt * 256) * 512) * 2; u.i0 = b * CTXL; u.i1 = 1; u.i3 = 1; }
        return true; }
    __device__ __forceinline__ unsigned aoff(const Unit&, int R, int C) const { return (unsigned)(R * 512 + C) * 2u; }
};
struct QkvSched { static constexpr bool GATHER = false; const unsigned char* ws; int G, c;
    __device__ __forceinline__ bool next(int i, Unit& u) const { const int L = i * G + c; if (L >= 392) return false;
        const char* A0 = (const char*)(ws + WS_A0);
        if (L < 324) { int pm, pn; if (L < 320) { pg8::tile_order(L, 32, 10, pm, pn); pm += 2; } else { pm = (L - 320) >> 1; pn = 8 + ((L - 320) & 1); }
            u.a = A0 + (size_t)pm * 256 * D * 2; u.b = (const char*)(ws + WS_WQK) + (size_t)pn * 256 * D * 2; u.i0 = pm * 256; u.i1 = pn; u.i2 = 0; u.i3 = 0; }
        else { const int v = L - 324, mt = v & 1, ntile = v >> 1;
            u.a = (const char*)(ws + WS_WV) + (size_t)mt * 256 * D * 2; u.b = A0 + (size_t)ntile * 256 * D * 2; u.i0 = mt * 256; u.i1 = ntile; u.i2 = 1; u.i3 = 0; }
        return true; }
    __device__ __forceinline__ unsigned aoff(const Unit&, int R, int C) const { return (unsigned)(R * D + C) * 2u; }
};
struct EpiQkv { static constexpr bool PERM = true; bf16_t* QK; bf16_t* VT; const f32x2* rope;
    __device__ __forceinline__ void operator()(const f32x4 (&acc)[2][2][4][2], const Unit& u, int wr, int wc, int fr, int fq) const {
        const int r0 = u.i0 + wr * 64 + fr;
        if (u.i2) {
            const int col0 = u.i1 * 256 + wc * 32 + 8 * fq;
#pragma unroll
            for (int ai = 0; ai < 2; ++ai)
#pragma unroll
                for (int m = 0; m < 4; ++m) { bf16_t* rowp = VT + (size_t)(r0 + ai * 128 + m * 16) * T0 + col0;
#pragma unroll
                    for (int bj = 0; bj < 2; ++bj) { const f32x4 v0 = acc[ai][bj][m][0], v1 = acc[ai][bj][m][1];
                        u32x4 w; w.x = cvt_pk_bf16(v0[0], v0[1]); w.y = cvt_pk_bf16(v0[2], v0[3]); w.z = cvt_pk_bf16(v1[0], v1[1]); w.w = cvt_pk_bf16(v1[2], v1[3]);
                        *(GAS u32x4*)(rowp + bj * 128) = w; } }
            return; }
        const int col0 = u.i1 * 256 + wc * 32 + 8 * fq; const float qs = u.i1 < 8 ? QSCALE : 1.0f; const bool dorope = u.i0 >= TC;
        const int half = wc >> 1, f0 = (wc & 1) * 16 + fq * 4;
#pragma unroll
        for (int ai = 0; ai < 2; ++ai)
#pragma unroll
            for (int m = 0; m < 4; ++m) { const int row = r0 + ai * 128 + m * 16; bf16_t* rowp = QK + (size_t)row * 2560 + col0;
                f32x4 cs0 = {1.f, 0.f, 1.f, 0.f}, cs1 = {1.f, 0.f, 1.f, 0.f};
                if (dorope) { const int s = (row - TC) & (SEQ - 1), id = half ? (s & 63) : (s >> 6); const GAS f32x4* rp = (const GAS f32x4*)(rope + id * 32 + f0); cs0 = rp[0]; cs1 = rp[1]; }
#pragma unroll
                for (int bj = 0; bj < 2; ++bj) { const f32x4 x1 = acc[ai][bj][m][0], x2 = acc[ai][bj][m][1]; f32x4 o1, o2;
                    o1[0] = x1[0] * cs0[0] - x2[0] * cs0[1]; o2[0] = x2[0] * cs0[0] + x1[0] * cs0[1];
                    o1[1] = x1[1] * cs0[2] - x2[1] * cs0[3]; o2[1] = x2[1] * cs0[2] + x1[1] * cs0[3];
                    o1[2] = x1[2] * cs1[0] - x2[2] * cs1[1]; o2[2] = x2[2] * cs1[0] + x1[2] * cs1[1];
                    o1[3] = x1[3] * cs1[2] - x2[3] * cs1[3]; o2[3] = x2[3] * cs1[2] + x1[3] * cs1[3];
                    o1 = o1 * qs; o2 = o2 * qs;
                    u32x4 w; w.x = cvt_pk_bf16(o1[0], o1[1]); w.y = cvt_pk_bf16(o1[2], o1[3]); w.z = cvt_pk_bf16(o2[0], o2[1]); w.w = cvt_pk_bf16(o2[2], o2[3]);
                    *(GAS u32x4*)(rowp + bj * 128) = w; } }
    }
};
typedef int i32x4 __attribute__((ext_vector_type(4)));
__device__ __forceinline__ void moe_tables(const Frame& F, int NT, int G, int c) {
    LAS int* tb = (LAS int*)(F.lds + MISC_OFF);
    LAS i32x4* ut = (LAS i32x4*)(F.lds + MISC_OFF + 1152);
    if (F.wave == 0) {
        const int* st = (const int*)(F.ws + WS_EXPT); const int* cn = st + 128;
        const int t = (cn[F.lane] + 255) >> 8, s0 = st[F.lane], t64 = (cn[64] + 255) >> 8, s64 = st[64];
        int incl = t * NT;
#pragma unroll
        for (int o = 1; o < 64; o <<= 1) { const int x = __shfl_up(incl, o); if (F.lane >= o) incl += x; }
        const int lo = incl - t * NT, cum64 = __shfl(incl, 63), total = cum64 + t64 * NT;
        if (F.lane == 0) tb[65] = total;
        for (int i = 0; i < 32; ++i) { const int L = i * G + c; i32x4 v = {0, 0, 0, 0};
            if (L < total) {
                if (L >= cum64) { const int rem = L - cum64, mt = rem % t64, nt = rem / t64; v = (i32x4){64, s64 + mt * 256, nt, 1}; }
                else { const unsigned long long hit = __ballot(L >= lo && L < incl); const int e = __builtin_ctzll(hit);
                    const int elo = __shfl(lo, e), et = __shfl(t, e), es = __shfl(s0, e); const int rem = L - elo, mt = rem % et, nt = rem / et; v = (i32x4){e, es + mt * 256, nt, 1}; } }
            if (F.lane == 0) ut[i] = v; }
    }
    __syncthreads();
}
__device__ __forceinline__ bool moe_short(const Frame& F, int c) { const LAS int* tb = (const LAS int*)(F.lds + MISC_OFF); const int total = tb[65]; const int mx = (total + F.G - 1) / F.G; const int mine = total > c ? (total - c - 1) / F.G + 1 : 0; return mine < mx; }
struct MoeSched { static constexpr bool GATHER = true;
    const unsigned char* ws; LAS i32x4* ut; const int* slot_tok; int layer;
    __device__ __forceinline__ bool next(int i, Unit& u) const { if (i >= 32) return false; const i32x4 v = ut[i]; if (!v[3]) return false;
        u.a = (const char*)(ws + WS_A0); u.b = (const char*)(ws + WS_WGU) + (size_t)layer * WGU8_L + (size_t)v[0] * WGU8_E + (size_t)v[2] * 256 * D;
        u.i0 = v[1]; u.i1 = v[2]; u.i2 = v[0]; u.i3 = 0; return true; }
    __device__ __forceinline__ unsigned aoff(const Unit& u, int R, int C) const { return (unsigned)(slot_tok[u.i0 + R] * (D / 2) + C) * 2u; }
};
struct EpiGateUp { static constexpr bool PERM = true; bf16_t* ACT;
    __device__ __forceinline__ void operator()(const f32x4 (&acc)[2][2][4][2], const Unit& u, int wr, int wc, int fr, int fq) const {
        const int r0 = u.i0 + wr * 64 + fr, col0 = u.i1 * 128 + wc * 32 + 8 * fq;
#pragma unroll
        for (int ai = 0; ai < 2; ++ai)
#pragma unroll
            for (int m = 0; m < 4; ++m) { f32x4 h0, h1;
#pragma unroll
                for (int j = 0; j < 4; ++j) { h0[j] = silu_f(acc[ai][0][m][0][j]) * acc[ai][1][m][0][j]; h1[j] = silu_f(acc[ai][0][m][1][j]) * acc[ai][1][m][1][j]; }
                u32x2 w; w.x = pk4_fp8(h0[0], h0[1], h0[2], h0[3]); w.y = pk4_fp8(h1[0], h1[1], h1[2], h1[3]);
                *(GAS u32x2*)((unsigned char*)ACT + (size_t)(r0 + ai * 128 + m * 16) * EDIM + col0) = w; }
    }
};
struct MoeDownSched { static constexpr bool GATHER = false; const unsigned char* ws; LAS i32x4* ut; int layer;
    __device__ __forceinline__ bool next(int i, Unit& u) const { if (i >= 32) return false; const i32x4 v = ut[i]; if (!v[3]) return false;
        u.a = (const char*)(ws + WS_ACT) + (size_t)v[1] * EDIM; u.b = (const char*)(ws + WS_WD) + (size_t)layer * WD8_L + (size_t)v[0] * WD8_E + (size_t)v[2] * 256 * EDIM;
        u.i0 = v[1]; u.i1 = 1; u.i2 = v[2] * 256; u.i3 = 0; return true; }
    __device__ __forceinline__ unsigned aoff(const Unit&, int R, int C) const { return (unsigned)(R * (EDIM / 2) + C) * 2u; }
};

__device__ __forceinline__ void phase_sgu(const Frame& F, const Args& a) {
    LAS bf16_t* wA = (LAS bf16_t*)F.lds;
    LAS bf16_t* vT = (LAS bf16_t*)(F.lds + 34816);
    const bf16_t* Z = (const bf16_t*)(F.ws + WS_Z); bf16_t* MIX = (bf16_t*)(F.ws + WS_MIX);
    const int fr = F.lane & 15, fq = F.lane >> 4;
    for (int rnd = 0;; ++rnd) { const int unit = (F.G != 256) ? F.bid + rnd * F.G : rnd == 0 ? F.bid : (rnd == 1 && F.bid >= 16 && F.bid < 32) ? 256 + F.bid - 16 : (1 << 20); if (unit >= 272) break;
        const int chunk = unit >> 2, g = unit & 3, r0 = chunk * 128;
        const float* wsrc = a.in[I_SWS] + (size_t)g * 128 * 128;
#pragma unroll
        for (int i = 0; i < 8; ++i) { const int idx = F.tid + 512 * i, p = idx >> 5, q4 = idx & 31; const f32x4 v = *(const GAS f32x4*)(wsrc + p * 128 + 4 * q4);
            u32x2 w; w.x = pk2(v[0], v[1]); w.y = pk2(v[2], v[3]); *(LAS u32x2*)(wA + p * 136 + 4 * q4) = w; }
        { const int rg = F.tid >> 5, c8 = F.tid & 31; const int cb = g * 256 + 8 * c8;
          const f32x4 lg0 = *(const GAS f32x4*)(a.in[I_SLNG] + cb), lg1 = *(const GAS f32x4*)(a.in[I_SLNG] + cb + 4), lb0 = *(const GAS f32x4*)(a.in[I_SLNB] + cb), lb1 = *(const GAS f32x4*)(a.in[I_SLNB] + cb + 4);
#pragma unroll 2
          for (int pass = 0; pass < 8; ++pass) { const int q = pass * 16 + rg;
            const u32x4 raw = *(const GAS u32x4*)(Z + (size_t)(r0 + q) * 3072 + 2048 + cb);
            float x[8] = {bflo(raw.x), bfhi(raw.x), bflo(raw.y), bfhi(raw.y), bflo(raw.z), bfhi(raw.z), bflo(raw.w), bfhi(raw.w)};
            float s = 0.f;
#pragma unroll
            for (int i = 0; i < 8; ++i) s += x[i];
#pragma unroll
            for (int o = 1; o < 32; o <<= 1) s += __shfl_xor(s, o);
            const float mean = s * (1.0f / 256.0f); float ss = 0.f;
#pragma unroll
            for (int i = 0; i < 8; ++i) { x[i] -= mean; ss += x[i] * x[i]; }
#pragma unroll
            for (int o = 1; o < 32; o <<= 1) ss += __shfl_xor(ss, o);
            const float rstd = rsqrtf(ss * (1.0f / 256.0f) + LN_EPS);
#pragma unroll
            for (int i = 0; i < 8; ++i) { const float gg = i < 4 ? lg0[i & 3] : lg1[i & 3], bb = i < 4 ? lb0[i & 3] : lb1[i & 3];
                vT[(8 * c8 + i) * 136 + (q ^ ((c8 & 15) << 3))] = (bf16_t)f2bf(x[i] * rstd * gg + bb); } } }
        __syncthreads();
        const int pm = F.wave & 1, cn = F.wave >> 1;
        f32x4 acc[4][4];
#pragma unroll
        for (int m = 0; m < 4; ++m)
#pragma unroll
            for (int n = 0; n < 4; ++n) acc[m][n] = (f32x4){0.f, 0.f, 0.f, 0.f};
#pragma unroll
        for (int kk = 0; kk < 4; ++kk) { bf16x8 am[4], bn[4];
#pragma unroll
            for (int m = 0; m < 4; ++m) am[m] = *(const LAS bf16x8*)(wA + (64 * pm + 16 * m + fr) * 136 + 32 * kk + 8 * fq);
#pragma unroll
            for (int n = 0; n < 4; ++n) { const int cr = 64 * cn + 16 * n + fr; bn[n] = *(const LAS bf16x8*)(vT + cr * 136 + ((32 * kk + 8 * fq) ^ (((cr >> 3) & 15) << 3))); }
#pragma unroll
            for (int m = 0; m < 4; ++m)
#pragma unroll
                for (int n = 0; n < 4; ++n) acc[m][n] = __builtin_amdgcn_mfma_f32_16x16x32_bf16(bn[n], am[m], acc[m][n], 0, 0, 0); }
#pragma unroll
        for (int m = 0; m < 4; ++m) { const int p = 64 * pm + 16 * m + fr, row = r0 + p; const float bias = a.in[I_SBS][g * 128 + p];
#pragma unroll
            for (int n = 0; n < 4; ++n) { const int c = g * 256 + 64 * cn + 16 * n + 4 * fq;
                const u32x2 uu = *(const GAS u32x2*)(Z + (size_t)row * 3072 + 1024 + c);
                const float s0 = bflo(uu.x) * (acc[m][n][0] + bias), s1 = bfhi(uu.x) * (acc[m][n][1] + bias), s2 = bflo(uu.y) * (acc[m][n][2] + bias), s3 = bfhi(uu.y) * (acc[m][n][3] + bias);
                u32x2 w; w.x = pk2(s0, s1); w.y = pk2(s2, s3); *(GAS u32x2*)(MIX + (size_t)row * D + 1024 + c) = w; } }
        __syncthreads();
    }
}

constexpr int HB_LD = 2056;
__device__ __forceinline__ void phase_ln_router(const Frame& F, const Args& a, int layer) {
    LAS bf16_t* hb = (LAS bf16_t*)F.lds;
    LAS float* part = (LAS float*)F.lds;
    LAS int* histw = (LAS int*)(F.lds + 141312);
    bf16_t* X = (bf16_t*)(F.ws + WS_X); bf16_t* A0 = (bf16_t*)(F.ws + WS_A0);
    int* SE = (int*)(F.ws + WS_SELE); float* SW = (float*)(F.ws + WS_SELW); int* HIST = (int*)(F.ws + WS_HIST);
    const int tok0 = layer ? TC : 0, TPB = layer ? 32 : 34;
    const float* lng = a.in[I_LNMG] + layer * D; const float* lnb = a.in[I_LNMB] + layer * D;
    const bf16_t* rwh = (const bf16_t*)(F.ws + WS_RWH) + (size_t)layer * NEXP * D; const bf16_t* rwl = (const bf16_t*)(F.ws + WS_RWL) + (size_t)layer * NEXP * D;
    const float rbias = a.in[I_RB][layer * NEXP + F.lane];
    const int fr = F.lane & 15, fq = F.lane >> 4;
    for (int vb = F.bid; vb < 256; vb += F.G) {
        const int rb = tok0 + vb * TPB; int mycnt = 0;
        f32x4 psc[8]; int rcur = -1; const float* sh2p = nullptr;
        u32x2 nx[8];
        if (F.wave < TPB) {
#pragma unroll
            for (int i = 0; i < 8; ++i) nx[i] = *(const GAS u32x2*)(X + (size_t)(rb + F.wave) * D + 4 * F.lane + 256 * i); }
        for (int j = F.wave; j < TPB; j += 8) { const int row = rb + j; bf16_t* xr = X + (size_t)row * D;
            f32x4 v[8]; float s = 0.f;
#pragma unroll
            for (int i = 0; i < 8; ++i) { const u32x2 p = nx[i]; v[i] = (f32x4){bflo(p.x), bfhi(p.x), bflo(p.y), bfhi(p.y)}; s += (v[i][0] + v[i][1]) + (v[i][2] + v[i][3]); }
            if (j + 8 < TPB) {
#pragma unroll
                for (int i = 0; i < 8; ++i) nx[i] = *(const GAS u32x2*)(xr + (size_t)8 * D + 4 * F.lane + 256 * i); }
            const int r = modrow(row);
            if (r != rcur) { rcur = r; sh2p = modp(F.ws, layer, r, 3); const float* sc2 = modp(F.ws, layer, r, 4);
#pragma unroll
                for (int i = 0; i < 8; ++i) { const int c = 4 * F.lane + 256 * i; psc[i] = *(const GAS f32x4*)(sc2 + c) + 1.0f; } }
            const float mean = wave_sum(s) * (1.0f / D); float ss = 0.f;
#pragma unroll
            for (int i = 0; i < 8; ++i) { v[i] = v[i] - mean; ss += (v[i][0] * v[i][0] + v[i][1] * v[i][1]) + (v[i][2] * v[i][2] + v[i][3] * v[i][3]); }
            const float rstd = rsqrtf(wave_sum(ss) * (1.0f / D) + LN_EPS);
#pragma unroll
            for (int i = 0; i < 8; ++i) { const int c = 4 * F.lane + 256 * i;
                const f32x4 lat = v[i] * rstd * *(const GAS f32x4*)(lng + c) + *(const GAS f32x4*)(lnb + c);
                { u32x2 wl; wl.x = pk2(lat[0], lat[1]); wl.y = pk2(lat[2], lat[3]); *(GAS u32x2*)(xr + c) = wl; }
                const f32x4 h = lat * psc[i] + *(const GAS f32x4*)(sh2p + c);
                u32x2 w; w.x = pk2(h[0], h[1]); w.y = pk2(h[2], h[3]); *(GAS unsigned*)((unsigned char*)A0 + (size_t)row * D + c) = pk4_fp8(h[0], h[1], h[2], h[3]);
                *(LAS u32x2*)(hb + j * HB_LD + c) = w; } }
        __syncthreads();
        f32x4 acc[3][4];
#pragma unroll
        for (int mt = 0; mt < 3; ++mt)
#pragma unroll
            for (int nt = 0; nt < 4; ++nt) acc[mt][nt] = (f32x4){0.f, 0.f, 0.f, 0.f};
        { int arow[3];
#pragma unroll
          for (int mt = 0; mt < 3; ++mt) { const int rr = 16 * mt + fr; arow[mt] = (rr < TPB ? rr : TPB - 1) * HB_LD; }
#pragma unroll 2
          for (int kk = 0; kk < 8; ++kk) { const int k0 = F.wave * 256 + 32 * kk + 8 * fq;
              bf16x8 bh[4], bl[4], af[3];
#pragma unroll
              for (int nt = 0; nt < 4; ++nt) { bh[nt] = *(const GAS bf16x8*)(rwh + (size_t)(16 * nt + fr) * D + k0); bl[nt] = *(const GAS bf16x8*)(rwl + (size_t)(16 * nt + fr) * D + k0); }
#pragma unroll
              for (int mt = 0; mt < 3; ++mt) af[mt] = *(const LAS bf16x8*)(hb + arow[mt] + k0);
#pragma unroll
              for (int mt = 0; mt < 3; ++mt)
#pragma unroll
                  for (int nt = 0; nt < 4; ++nt) { acc[mt][nt] = __builtin_amdgcn_mfma_f32_16x16x32_bf16(af[mt], bh[nt], acc[mt][nt], 0, 0, 0);
                      acc[mt][nt] = __builtin_amdgcn_mfma_f32_16x16x32_bf16(af[mt], bl[nt], acc[mt][nt], 0, 0, 0); } } }
        __syncthreads();
#pragma unroll
        for (int mt = 0; mt < 3; ++mt)
#pragma unroll
            for (int nt = 0; nt < 4; ++nt)
#pragma unroll
                for (int j = 0; j < 4; ++j) part[(F.wave * 48 + 16 * mt + 4 * fq + j) * 64 + 16 * nt + fr] = acc[mt][nt][j];
        __syncthreads();
        for (int j = F.wave; j < TPB; j += 8) { const int row = rb + j; float logit = 0.f;
#pragma unroll
            for (int w = 0; w < 8; ++w) logit += part[(w * 48 + j) * 64 + F.lane];
            const float sg = 1.0f / (1.0f + expf(-logit)), bsd = sg + rbias;
            float m1 = bsd;
#pragma unroll
            for (int o = 1; o < 8; o <<= 1) m1 = fmaxf(m1, __shfl_xor(m1, o));
            int idx = (bsd == m1) ? (F.lane & 7) : 8;
#pragma unroll
            for (int o = 1; o < 8; o <<= 1) idx = min(idx, __shfl_xor(idx, o));
            float m2 = ((F.lane & 7) == idx) ? -INFINITY : bsd;
#pragma unroll
            for (int o = 1; o < 8; o <<= 1) m2 = fmaxf(m2, __shfl_xor(m2, o));
            const float gs = m1 + m2; const int mygrp = F.lane >> 3; int grank = 0;
#pragma unroll
            for (int gg = 0; gg < 8; ++gg) { const float og = __builtin_bit_cast(float, __builtin_amdgcn_readlane(__builtin_bit_cast(int, gs), gg * 8)); grank += (og > gs || (og == gs && gg < mygrp)) ? 1 : 0; }
            const bool gsel = grank < 4; const float cand = gsel ? bsd : -INFINITY; int rank = 0;
#pragma unroll 8
            for (int e2 = 0; e2 < 64; ++e2) { const float ov = __builtin_bit_cast(float, __builtin_amdgcn_readlane(__builtin_bit_cast(int, cand), e2)); rank += (ov > cand || (ov == cand && e2 < F.lane)) ? 1 : 0; }
            const bool sel = gsel && rank < TOPK;
            const float wsum = wave_sum(sel ? sg : 0.f);
            if (sel) { SE[row * 8 + rank] = F.lane; SW[row * 8 + rank] = sg / wsum * 2.5f; mycnt += 1; } }
        histw[F.wave * 64 + F.lane] = mycnt;
        __syncthreads();
        if (F.tid < 64) { int s = 0;
#pragma unroll
            for (int w = 0; w < 8; ++w) s += histw[w * 64 + F.tid];
            HIST[vb * 64 + F.tid] = s; }
        __syncthreads();
    }
}

__device__ __forceinline__ void phase_scatter(const Frame& F, int layer) {
    LAS int* pall = (LAS int*)F.lds;
    LAS int* plo = pall + 512;
    LAS int* st_l = plo + 512;
    LAS int* sel_l = st_l + 64;
    LAS int* misc = sel_l + 288;
    const int* HIST = (const int*)(F.ws + WS_HIST); const int* SE = (const int*)(F.ws + WS_SELE);
    int* EXPT = (int*)(F.ws + WS_EXPT); int* SLOT_TOK = (int*)(F.ws + WS_SLOTTOK); int* TOK_SLOT = (int*)(F.ws + WS_TOKSLOT);
    const int tok0 = layer ? TC : 0, TPB = layer ? 32 : 34, ntok = T0 - tok0;
    for (int vb = F.bid; vb < 256; vb += F.G) {
        int all = 0, lo = 0;
        for (int b = F.wave * 32; b < F.wave * 32 + 32; ++b) { const int h = HIST[b * 64 + F.lane]; all += h; lo += (b < vb) ? h : 0; }
        pall[F.wave * 64 + F.lane] = all; plo[F.wave * 64 + F.lane] = lo;
        const int rb = tok0 + vb * TPB;
        for (int i = F.tid; i < TPB * 8; i += NTHREADS) sel_l[i] = SE[rb * 8 + i];
        __syncthreads();
        if (F.wave == 0) { int tot = 0, base = 0;
#pragma unroll
            for (int w = 0; w < 8; ++w) { tot += pall[w * 64 + F.lane]; base += plo[w * 64 + F.lane]; }
            const int padded = (tot + 255) & ~255; int incl = padded;
#pragma unroll
            for (int o = 1; o < 64; o <<= 1) { const int t = __shfl_up(incl, o); if (F.lane >= o) incl += t; }
            const int start = incl - padded, total_pad = __shfl(incl, 63);
            st_l[F.lane] = start + base; if (F.lane == 0) misc[0] = total_pad;
            if (vb == 0) { EXPT[F.lane] = start; EXPT[128 + F.lane] = tot; if (F.lane == 0) { EXPT[64] = total_pad; EXPT[128 + 64] = ntok; }
                for (int s = tot; s < padded; ++s) SLOT_TOK[start + s] = tok0; } }
        __syncthreads();
        if (F.tid < TPB * 8) { const int e = sel_l[F.tid]; int rank = 0;
            for (int p = 0; p < F.tid; ++p) rank += (sel_l[p] == e) ? 1 : 0;
            const int slot = st_l[e] + rank, t = rb + (F.tid >> 3);
            SLOT_TOK[slot] = t; TOK_SLOT[t * 8 + (F.tid & 7)] = slot; }
        if (F.tid < TPB) SLOT_TOK[misc[0] + (rb - tok0) + F.tid] = rb + F.tid;
        __syncthreads();
    }
}

__device__ __forceinline__ void phase_combine(const Frame& F, const Args& a, int layer) {
    bf16_t* X = (bf16_t*)(F.ws + WS_X); bf16_t* A0 = (bf16_t*)(F.ws + WS_A0); const unsigned char* YS = F.ws + WS_YS;
    const int* TOK_SLOT = (const int*)(F.ws + WS_TOKSLOT); const float* SW = (const float*)(F.ws + WS_SELW); const int* EXPT = (const int*)(F.ws + WS_EXPT);
    const int tok0 = layer ? TC : 0, TPB = layer ? 32 : 34; const int start64 = EXPT[64];
    LAS float* P = (LAS float*)F.lds;
    for (int i = F.tid; i < 11 * (D / 4); i += NTHREADS) { const int t = i / (D / 4), c = 4 * (i % (D / 4)); f32x4 v;
        if (t == 0) v = *(const GAS f32x4*)(a.in[I_LNFG] + layer * D + c);
        else if (t == 1) v = *(const GAS f32x4*)(a.in[I_LNFB] + layer * D + c);
        else { const int r = (t - 2) / 3, k = (t - 2) % 3;
            if (k == 0) v = *(const GAS f32x4*)(modp(F.ws, layer, r, 5) + c);
            else if (layer == 0) { v = *(const GAS f32x4*)(modp(F.ws, 1, r, k == 1 ? 1 : 0) + c); if (k == 1) v = v + 1.0f; }
            else v = (f32x4){0.f, 0.f, 0.f, 0.f}; }
        *(LAS f32x4*)(P + t * D + c) = v; }
    __syncthreads();
    for (int vb = F.bid; vb < 256; vb += F.G) {
        for (int j = F.wave; j < TPB; j += 8) { const int row = tok0 + vb * TPB + j;
            f32x4 f[8];
            { const unsigned char* ys = YS + (size_t)(start64 + row - tok0) * D;
#pragma unroll
              for (int i = 0; i < 8; ++i) f[i] = up4_fp8(*(const GAS unsigned*)(ys + 4 * F.lane + 256 * i)) * 0.0625f; }
#pragma unroll 2
            for (int jj = 0; jj < 8; ++jj) { const int slot = TOK_SLOT[row * 8 + jj]; const float w = SW[row * 8 + jj] * 0.0625f; const unsigned char* ys = YS + (size_t)slot * D;
#pragma unroll
                for (int i = 0; i < 8; ++i) f[i] += up4_fp8(*(const GAS unsigned*)(ys + 4 * F.lane + 256 * i)) * w; }
            const int r = modrow(row); bf16_t* xr = X + (size_t)row * D; float s = 0.f;
            const LAS float* pg2 = P + (2 + 3 * r) * D;
#pragma unroll
            for (int i = 0; i < 8; ++i) { const int c = 4 * F.lane + 256 * i; const u32x2 p = *(const GAS u32x2*)(xr + c); const f32x4 xv = {bflo(p.x), bfhi(p.x), bflo(p.y), bfhi(p.y)};
                f[i] = xv * ALPHA + *(const LAS f32x4*)(pg2 + c) * f[i]; s += (f[i][0] + f[i][1]) + (f[i][2] + f[i][3]); }
            const float mean = wave_sum(s) * (1.0f / D); float ss = 0.f;
#pragma unroll
            for (int i = 0; i < 8; ++i) { f[i] = f[i] - mean; ss += (f[i][0] * f[i][0] + f[i][1] * f[i][1]) + (f[i][2] * f[i][2] + f[i][3] * f[i][3]); }
            const float rstd = rsqrtf(wave_sum(ss) * (1.0f / D) + LN_EPS);
            if (layer == 0) { const LAS float* psc = P + (3 + 3 * r) * D; const LAS float* psh = P + (4 + 3 * r) * D;
#pragma unroll
                for (int i = 0; i < 8; ++i) { const int c = 4 * F.lane + 256 * i;
                    const f32x4 lat = f[i] * rstd * *(const LAS f32x4*)(P + c) + *(const LAS f32x4*)(P + D + c);
                    { u32x2 wl; wl.x = pk2(lat[0], lat[1]); wl.y = pk2(lat[2], lat[3]); *(GAS u32x2*)(xr + c) = wl; }
                    const f32x4 h = lat * *(const LAS f32x4*)(psc + c) + *(const LAS f32x4*)(psh + c);
                    u32x2 w; w.x = pk2(h[0], h[1]); w.y = pk2(h[2], h[3]); *(GAS u32x2*)(A0 + (size_t)row * D + c) = w; } }
            else { float* o = a.out + (size_t)(row - TC) * D;
#pragma unroll
                for (int i = 0; i < 8; ++i) { const int c = 4 * F.lane + 256 * i; *(GAS f32x4*)(o + c) = f[i] * rstd * *(const LAS f32x4*)(P + c) + *(const LAS f32x4*)(P + D + c); } }
        }
    }
}

__device__ __forceinline__ void phase_attention(const Frame& F, const Args& a) {
    constexpr int ABUF = 35840;
    const bf16_t* QK = (const bf16_t*)(F.ws + WS_Z); const bf16_t* VT = (const bf16_t*)(F.ws + WS_YTL); bf16_t* O = (bf16_t*)(F.ws + WS_MIX);
    const int fr = F.lane & 15, fq = F.lane >> 4;
    const int key0 = F.tid >> 4, c16 = F.tid & 15, dim0 = F.tid >> 3, c8 = F.tid & 7;
    for (int unit = ((F.G % 8 == 0) ? (F.bid % 8) * (F.G / 8) + F.bid / 8 : F.bid); unit < 256; unit += F.G) {
        const int b = unit >> 7, h = (unit >> 5) & 3, n = unit & 31;
        const int kt_lo = (2 * n - 2) < 0 ? 0 : (2 * n - 2), kt_hi = (2 * n + 3) > 63 ? 63 : (2 * n + 3), nband = kt_hi - kt_lo + 1, ntile = nband + 4, nstep = 2 * ntile;
        u32x4 kreg[2], vreg[2];
        const bf16_t* kbase = QK + 2048 + h * 128 + 8 * c16; const bf16_t* vbase = VT + (size_t)(h * 128 + dim0) * T0 + 8 * c8;
#define ATT_LOAD(step_) do { const int ti_ = (step_) % ntile; const bool cx_ = ti_ >= nband; const int kt_ = cx_ ? (ti_ - nband) : (kt_lo + ti_); const int kr_ = cx_ ? (b * CTXL + 64 * kt_) : (TC + b * SEQ + 64 * kt_); \
            kreg[0] = *(const GAS u32x4*)(kbase + (size_t)(kr_ + key0) * 2560); kreg[1] = *(const GAS u32x4*)(kbase + (size_t)(kr_ + key0 + 32) * 2560); \
            vreg[0] = *(const GAS u32x4*)(vbase + kr_); vreg[1] = *(const GAS u32x4*)(vbase + (size_t)64 * T0 + kr_); } while (0)
#define ATT_STORE(buf_) do { LAS bf16_t* Ks_ = (LAS bf16_t*)(F.lds + (buf_) * ABUF); LAS bf16_t* Vs_ = (LAS bf16_t*)(F.lds + (buf_) * ABUF + 17408); \
            *(LAS u32x4*)(Ks_ + key0 * 136 + 8 * c16) = kreg[0]; *(LAS u32x4*)(Ks_ + (key0 + 32) * 136 + 8 * c16) = kreg[1]; \
            *(LAS u32x4*)(Vs_ + dim0 * 72 + 8 * c8) = vreg[0]; *(LAS u32x4*)(Vs_ + (dim0 + 64) * 72 + 8 * c8) = vreg[1]; } while (0)
        __syncthreads();
        ATT_LOAD(0); ATT_STORE(0);
        __syncthreads();
        bf16x8 aq[2][4]; float mrun[2], lrun[2]; f32x4 o[2][8]; int qh = 0, qpos0 = 0, qrow = 0;
        for (int step = 0; step < nstep; ++step) {
            const int ti = step % ntile, pass = step / ntile;
            if (step + 1 < nstep) ATT_LOAD(step + 1);
            if (ti == 0) {
                qh = h * 4 + 2 * pass + (F.wave >> 2); const int rows0 = (F.wave & 3) * 32; qpos0 = n * 128 + rows0; qrow = TC + b * SEQ + qpos0;
#pragma unroll
                for (int m = 0; m < 2; ++m)
#pragma unroll
                    for (int kk = 0; kk < 4; ++kk) aq[m][kk] = *(const GAS bf16x8*)(QK + (size_t)(qrow + 16 * m + fr) * 2560 + qh * 128 + 32 * kk + 8 * fq);
                const float sink = a.in[I_SINK][qh] * 1.4426950408889634f;
                mrun[0] = sink; mrun[1] = sink; lrun[0] = 1.f; lrun[1] = 1.f;
#pragma unroll
                for (int m = 0; m < 2; ++m)
#pragma unroll
                    for (int nd = 0; nd < 8; ++nd) o[m][nd] = (f32x4){0.f, 0.f, 0.f, 0.f};
            }
            const bool isctx = ti >= nband; const int kt = isctx ? (ti - nband) : (kt_lo + ti);
            const LAS bf16_t* Ks = (const LAS bf16_t*)(F.lds + (step & 1) * ABUF); const LAS bf16_t* Vs = (const LAS bf16_t*)(F.lds + (step & 1) * ABUF + 17408);
            f32x4 s[2][4];
#pragma unroll
            for (int m = 0; m < 2; ++m)
#pragma unroll
                for (int nn = 0; nn < 4; ++nn) s[m][nn] = (f32x4){0.f, 0.f, 0.f, 0.f};
#pragma unroll
            for (int kk = 0; kk < 4; ++kk)
#pragma unroll
                for (int nn = 0; nn < 4; ++nn) { const bf16x8 kf = *(const LAS bf16x8*)(Ks + (16 * nn + fr) * 136 + 32 * kk + 8 * fq);
#pragma unroll
                    for (int m = 0; m < 2; ++m) s[m][nn] = __builtin_amdgcn_mfma_f32_16x16x32_bf16(kf, aq[m][kk], s[m][nn], 0, 0, 0); }
            bf16x8 pf[2][2];
#pragma unroll
            for (int m = 0; m < 2; ++m) {
                if (!isctx && (64 * kt + 63 - qpos0 > 128 || qpos0 + 31 - 64 * kt > 128)) { const int qpos = qpos0 + 16 * m + fr;
#pragma unroll
                    for (int nn = 0; nn < 4; ++nn)
#pragma unroll
                        for (int j = 0; j < 4; ++j) { const int d = 64 * kt + 16 * nn + 4 * fq + j - qpos; if (d > 128 || d < -128) s[m][nn][j] = -INFINITY; } }
                float mx = s[m][0][0];
#pragma unroll
                for (int nn = 0; nn < 4; ++nn)
#pragma unroll
                    for (int j = 0; j < 4; ++j) mx = fmaxf(mx, s[m][nn][j]);
                mx = fmaxf(mx, __shfl_xor(mx, 16)); mx = fmaxf(mx, __shfl_xor(mx, 32));
                const float mnew = fmaxf(mrun[m], mx), alpha = __builtin_amdgcn_exp2f(mrun[m] - mnew); mrun[m] = mnew;
                float rs = 0.f;
#pragma unroll
                for (int nn = 0; nn < 4; ++nn)
#pragma unroll
                    for (int j = 0; j < 4; ++j) { const float p = __builtin_amdgcn_exp2f(s[m][nn][j] - mnew); s[m][nn][j] = p; rs += p; }
                rs += __shfl_xor(rs, 16); rs += __shfl_xor(rs, 32);
                lrun[m] = lrun[m] * alpha + rs;
#pragma unroll
                for (int nd = 0; nd < 8; ++nd) o[m][nd] = o[m][nd] * alpha;
#pragma unroll
                for (int ks = 0; ks < 2; ++ks) { u32x4 w; w.x = cvt_pk_bf16(s[m][2 * ks][0], s[m][2 * ks][1]); w.y = cvt_pk_bf16(s[m][2 * ks][2], s[m][2 * ks][3]);
                    w.z = cvt_pk_bf16(s[m][2 * ks + 1][0], s[m][2 * ks + 1][1]); w.w = cvt_pk_bf16(s[m][2 * ks + 1][2], s[m][2 * ks + 1][3]); pf[m][ks] = __builtin_bit_cast(bf16x8, w); }
            }
#pragma unroll
            for (int ks = 0; ks < 2; ++ks)
#pragma unroll
                for (int nd = 0; nd < 8; ++nd) { const LAS bf16_t* vp = Vs + (16 * nd + fr) * 72 + 32 * ks + 4 * fq;
                    u32x4 w; const u32x2 lo = *(const LAS u32x2*)vp, hi = *(const LAS u32x2*)(vp + 16); w.x = lo.x; w.y = lo.y; w.z = hi.x; w.w = hi.y;
                    const bf16x8 vf = __builtin_bit_cast(bf16x8, w);
#pragma unroll
                    for (int m = 0; m < 2; ++m) o[m][nd] = __builtin_amdgcn_mfma_f32_16x16x32_bf16(vf, pf[m][ks], o[m][nd], 0, 0, 0); }
            if (ti == ntile - 1) {
#pragma unroll
                for (int m = 0; m < 2; ++m) { const float inv = 1.0f / lrun[m]; bf16_t* op = O + (size_t)(qrow + 16 * m + fr) * D + qh * 128 + 4 * fq;
#pragma unroll
                    for (int nd = 0; nd < 8; ++nd) { const f32x4 v = o[m][nd] * inv; u32x2 w; w.x = cvt_pk_bf16(v[0], v[1]); w.y = cvt_pk_bf16(v[2], v[3]); *(GAS u32x2*)(op + 16 * nd) = w; } }
            }
            if (step + 1 < nstep) ATT_STORE((step + 1) & 1);
            __syncthreads();
        }
#undef ATT_LOAD
#undef ATT_STORE
    }
}

constexpr int NPHASE = 20;
__global__ void __launch_bounds__(NTHREADS, 2) mk_fwd(Args args) {
    extern __shared__ __attribute__((aligned(16))) unsigned char lds_raw[];
    Frame F; F.lds = (LAS unsigned char*)lds_raw; F.tid = threadIdx.x; F.lane = F.tid & 63; F.wave = __builtin_amdgcn_readfirstlane(F.tid >> 6); F.G = gridDim.x; F.bid = blockIdx.x; F.ws = args.ws;
    volatile LAS unsigned* MISC = (volatile LAS unsigned*)(F.lds + MISC_OFF + 1024);
    if (F.tid < 16) MISC[F.tid] = 0u;
    __syncthreads();
    unsigned* ctl = (unsigned*)(args.ws + WS_CTL);
    XcdBarrier bar; bar.bar = ctl + CW_BAR; bar.x = 0; bar.st = nullptr;
    if (!MK_PER_PHASE) bar = xcd_barrier_post(ctl + CW_BAR, MISC + 8);
    const int lo = args.ph_lo, hi = args.ph_hi;
    unsigned char* ws = args.ws;
#ifndef DUP_PHASE
#define DUP_PHASE -1
#endif
#define IN(k) (lo <= (k) && (k) < hi)
#define REP(k) for (int rep_ = 0; rep_ < ((k) == DUP_PHASE ? 2 : 1); ++rep_)
#define SEAM(k) do { if (IN(k) && IN((k) + 1)) xcd_barrier(bar); } while (0)
    LAS unsigned char* ring = F.lds;
    LAS i32x4* ut = (LAS i32x4*)(F.lds + MISC_OFF + 1152);
    constexpr int QD = 8, QD2 = 11, QG = 3, QM = 1, QS = 4;
    const int vcu = (F.G % 8 == 0) ? (F.bid % 8) * (F.G / 8) + F.bid / 8 : F.bid;

    if (IN(0)) REP(0) { conv_range(F, args, 0, cv::N3 + cv::HALFM); conv_range(F, args, cv::NG, cv::NG + cv::HALFM);
        __syncthreads(); p0_mod(F, args); p0_tables(F, args.in[I_RW]); }
    SEAM(0);
    if (IN(1)) REP(1) phase_modulate0(F, args);
    SEAM(1);
    if (IN(2)) REP(2) { DenseSched S{(const char*)(ws + WS_A0), (const char*)(ws + WS_WIN), D, D, 34, 12, F.G, F.bid}; EpiWin E{(bf16_t*)(ws + WS_Z)};
        pg8::gemm_phase<EpiWin, DenseSched>(ring, D, D, S, E); if (F.bid >= 408 - F.G) conv_pull(F, args, QD2); }
    SEAM(2);
    if (IN(3)) REP(3) { Dft1Sched S{ws, F.G, F.bid}; EpiBf16G E{(bf16_t*)(ws + WS_YTL), (bf16_t*)(ws + WS_YTC), SEQ, CTXL, 1.0f, 1.0f};
        pg8::gemm_phase<EpiBf16G, Dft1Sched>(ring, 256, 3072, S, E); __syncthreads(); phase_sgu(F, args); if (F.bid >= 2 * (272 - F.G)) conv_pull(F, args, QS); }
    SEAM(3);
    if (IN(4)) REP(4) phase_butterfly(F);
    SEAM(4);
    if (IN(5)) REP(5) { Dft2Sched S{ws, F.G, F.bid}; EpiBf16G E{(bf16_t*)(ws + WS_MIX), (bf16_t*)(ws + WS_MIX), D, D, 1.0f / 1024.0f, 1.0f / 256.0f};
        pg8::gemm_phase<EpiBf16G, Dft2Sched>(ring, 512, 512, S, E); if (F.bid >= 136) conv_pull(F, args, QS); }
    SEAM(5);
    if (IN(6)) REP(6) { DenseSched S{(const char*)(ws + WS_MIX), (const char*)(ws + WS_WOUT), D, D, 34, 8, F.G, F.bid}; EpiResid E{(bf16_t*)(ws + WS_X), args.in[I_X], args.in[I_CTX], ws, 0, 0};
        pg8::gemm_phase<EpiResid, DenseSched>(ring, D, D, S, E); if (F.bid >= 272 - F.G) conv_pull(F, args, QD); }
    SEAM(6);
    if (IN(7)) REP(7) phase_ln_router(F, args, 0);
    SEAM(7);
    if (IN(8)) REP(8) { phase_scatter(F, 0); conv_cleanup(F, args, cv::HALFM); }
    SEAM(8);
    if (IN(9)) REP(9) { moe_tables(F, 4, F.G, vcu); MoeSched S{ws, ut, (const int*)(ws + WS_SLOTTOK), 0}; EpiGateUp E{(bf16_t*)(ws + WS_ACT)};
        pg8::gemm_phase<EpiGateUp, MoeSched, true, true, 122>(ring, D / 2, D / 2, S, E); if (0 == 0 && moe_short(F, vcu)) conv_pull(F, args, QG); }
    SEAM(9);
    if (IN(10)) REP(10) { moe_tables(F, 8, F.G, vcu); MoeDownSched S{ws, ut, 0}; EpiYs8 E{ws + WS_YS};
        pg8::gemm_phase<EpiYs8, MoeDownSched, true, true, 122>(ring, EDIM / 2, EDIM / 2, S, E); if (0 == 0 && moe_short(F, vcu)) conv_pull(F, args, QM); }
    SEAM(10);
    if (IN(11)) REP(11) phase_combine(F, args, 0);
    SEAM(11);
    if (IN(12)) REP(12) { QkvSched S{ws, F.G, F.bid}; EpiQkv E{(bf16_t*)(ws + WS_Z), (bf16_t*)(ws + WS_YTL), (const f32x2*)(ws + WS_ROPE)};
        pg8::gemm_phase<EpiQkv, QkvSched>(ring, D, D, S, E); if (F.bid >= 392 - F.G) conv_pull(F, args, QD2); }
    SEAM(12);
    if (IN(13)) REP(13) phase_attention(F, args);
    SEAM(13);
    if (IN(14)) REP(14) { DenseSched S{(const char*)(ws + WS_MIX) + (size_t)TC * D * 2, (const char*)(ws + WS_WAO), D, D, 32, 8, F.G, F.bid}; EpiResid E{(bf16_t*)(ws + WS_X), nullptr, nullptr, ws, 1, TC};
        pg8::gemm_phase<EpiResid, DenseSched>(ring, D, D, S, E); }
    SEAM(14);
    if (IN(15)) REP(15) phase_ln_router(F, args, 1);
    SEAM(15);
    if (IN(16)) REP(16) { phase_scatter(F, 1); conv_cleanup(F, args, 4 * cv::HALFM); }
    SEAM(16);
    if (IN(17)) REP(17) { moe_tables(F, 4, F.G, vcu); MoeSched S{ws, ut, (const int*)(ws + WS_SLOTTOK), 1}; EpiGateUp E{(bf16_t*)(ws + WS_ACT)};
        pg8::gemm_phase<EpiGateUp, MoeSched, true, true, 122>(ring, D / 2, D / 2, S, E); if (1 == 0 && moe_short(F, vcu)) conv_pull(F, args, QD); }
    SEAM(17);
    if (IN(18)) REP(18) { moe_tables(F, 8, F.G, vcu); MoeDownSched S{ws, ut, 1}; EpiYs8 E{ws + WS_YS};
        pg8::gemm_phase<EpiYs8, MoeDownSched, true, true, 122>(ring, EDIM / 2, EDIM / 2, S, E); if (1 == 0 && moe_short(F, vcu)) conv_pull(F, args, QM); }
    SEAM(18);
    if (IN(19)) REP(19) phase_combine(F, args, 1);
#undef IN
#undef SEAM
}

extern "C" void kernel_launch(void* const* d_in, const int* in_sizes, int n_in, void* d_out, int out_size, void* d_ws, size_t ws_size, hipStream_t stream) {
    static int grid = 0;
    if (grid == 0) {
        if (n_in != 27 || out_size != TL * D || ws_size < WS_END) { fprintf(stderr, "kernel_launch: unexpected shapes (n_in %d out %d ws %zu)\n", n_in, out_size, ws_size); grid = -1; return; }
        int dev = 0, cus = 0, per_cu = 0;
        if (hipGetDevice(&dev) != hipSuccess || hipDeviceGetAttribute(&cus, hipDeviceAttributeMultiprocessorCount, dev) != hipSuccess) { grid = -1; return; }
        if (hipFuncSetAttribute((const void*)mk_fwd, hipFuncAttributeMaxDynamicSharedMemorySize, LDS_BYTES) != hipSuccess) { fprintf(stderr, "kernel_launch: hipFuncSetAttribute failed\n"); grid = -1; return; }
        if (hipOccupancyMaxActiveBlocksPerMultiprocessor(&per_cu, (const void*)mk_fwd, NTHREADS, LDS_BYTES) != hipSuccess || per_cu < 1) fprintf(stderr, "kernel_launch: occupancy query reports %d\n", per_cu);
        (void)hipGetLastError();
        grid = cus < 256 ? cus : 256;
    }
    if (grid < 0) return;
    (void)hipMemsetAsync((char*)d_ws + WS_CTL, 0, CTL_ZERO_BYTES, stream);
    Args a{};
    for (int i = 0; i < 27; ++i) a.in[i] = (const float*)d_in[i];
    a.out = (float*)d_out; a.ws = (unsigned char*)d_ws;
#if MK_PER_PHASE
    for (int p = 0; p < NPHASE; ++p) { a.ph_lo = p; a.ph_hi = p + 1; hipLaunchKernelGGL(mk_fwd, dim3(grid), dim3(NTHREADS), LDS_BYTES, stream, a); }
#else
    a.ph_lo = 0; a.ph_hi = NPHASE; hipLaunchKernelGGL(mk_fwd, dim3(grid), dim3(NTHREADS), LDS_BYTES, stream, a);
#endif
}
```

```cpp
#include <hip/hip_runtime.h>
#include <cstdio>
#include <cstdint>

#ifndef MK_PER_PHASE
#define MK_PER_PHASE 0
#endif

#define GAS __attribute__((address_space(1)))
#define LAS __attribute__((address_space(3)))
typedef unsigned short bf16_t;
typedef short bf16x8 __attribute__((ext_vector_type(8)));
typedef float f32x4 __attribute__((ext_vector_type(4)));
typedef float f32x2 __attribute__((ext_vector_type(2)));
typedef unsigned u32x4 __attribute__((ext_vector_type(4)));
typedef unsigned u32x2 __attribute__((ext_vector_type(2)));

constexpr int D = 2048, SEQ = 4096, CTXL = 256, NBATCH = 2;
constexpr int TC = NBATCH * CTXL;
constexpr int TL = NBATCH * SEQ;
constexpr int T0 = TC + TL;
constexpr int NEXP = 64, EDIM = 512, TOPK = 8;
constexpr int NE1 = NEXP + 1;
constexpr int SLOTS = 98304;
constexpr float ALPHA = 1.4142135623730951f;
constexpr float LN_EPS = 1e-6f;
constexpr float QSCALE = 0.08838834764831845f;

constexpr size_t MiB = 1u << 20;
constexpr size_t WS_CTL = 0, CTL_ZERO_BYTES = 32 * 1024;
constexpr size_t WS_MOD = 1 * MiB;
constexpr size_t WS_ROPE = 1 * MiB + 512 * 1024;
constexpr size_t WS_WCT = 2 * MiB;
constexpr size_t WS_T256 = 2 * MiB + 256 * 1024;
constexpr size_t WS_RWH = 2 * MiB + 512 * 1024;
constexpr size_t WS_SELE = 3 * MiB;
constexpr size_t WS_SELW = 3 * MiB + 512 * 1024;
constexpr size_t WS_HIST = 4 * MiB;
constexpr size_t WS_EXPT = 4 * MiB + 128 * 1024;
constexpr size_t WS_SLOTTOK = 4 * MiB + 256 * 1024;
constexpr size_t WS_TOKSLOT = 5 * MiB;
constexpr size_t WS_RWL = 6 * MiB;
constexpr size_t WS_WIN = 8 * MiB;
constexpr size_t WS_WOUT = 20 * MiB;
constexpr size_t WS_WQK = 28 * MiB;
constexpr size_t WS_WV = 38 * MiB;
constexpr size_t WS_WAO = 40 * MiB;
constexpr size_t WS_WGU = 48 * MiB;
constexpr size_t WGU_E = (size_t)1024 * 2048 * 2, WGU_L = 65 * WGU_E;
constexpr size_t WS_WD = WS_WGU + 2 * WGU_L;
constexpr size_t WD_E = (size_t)2048 * 512 * 2, WD_L = 65 * WD_E;
constexpr size_t WGU8_E = (size_t)1024 * 2048, WGU8_L = 65 * WGU8_E;
constexpr size_t WD8_E = (size_t)2048 * 512, WD8_L = 65 * WD8_E;
constexpr size_t WS_X = 832 * MiB;
constexpr size_t WS_A0 = 900 * MiB;
constexpr size_t WS_Z = 934 * MiB;
constexpr size_t WS_YTL = 985 * MiB;
constexpr size_t WS_YTC = 1017 * MiB;
constexpr size_t WS_GT = 1019 * MiB;
constexpr size_t WS_MIX = 1051 * MiB;
constexpr size_t WS_ACT = 1085 * MiB;
constexpr size_t WS_YS = 1181 * MiB;
constexpr size_t WS_END = 1565 * MiB;
static_assert(WS_WD + 2 * WD_L <= WS_X && WS_YS + (size_t)SLOTS * 2048 * 2 <= WS_END, "ws map");
constexpr int CW_BAR = 4096;
static_assert((CW_BAR + 3456) * 4 <= (int)CTL_ZERO_BYTES, "barrier words inside the per-call memset");

constexpr int RING_BYTES = 131072;
constexpr int MISC_OFF = 145408;
constexpr int LDS_BYTES = 147456;
constexpr int NWAVES = 8, NTHREADS = 512;

#define LDS_WAIT() asm volatile("s_waitcnt lgkmcnt(0)" ::: "memory")
#define VM_WAIT() asm volatile("s_waitcnt vmcnt(0)" ::: "memory")
__device__ __forceinline__ unsigned f2bf(float f) { unsigned u = __builtin_bit_cast(unsigned, f); return (u + 0x7fffu + ((u >> 16) & 1u)) >> 16; }
__device__ __forceinline__ unsigned pk2(float lo, float hi) { return f2bf(lo) | (f2bf(hi) << 16); }
__device__ __forceinline__ float bf2f(unsigned short b) { return __builtin_bit_cast(float, ((unsigned)b) << 16); }
__device__ __forceinline__ float bflo(unsigned w) { return __builtin_bit_cast(float, w << 16); }
__device__ __forceinline__ float bfhi(unsigned w) { return __builtin_bit_cast(float, w & 0xffff0000u); }
__device__ __forceinline__ float wave_sum(float v) {
#pragma unroll
    for (int o = 1; o < 64; o <<= 1) v += __shfl_xor(v, o);
    return v;
}
__device__ __forceinline__ float gelu_tanh(float x) { const float u = 0.7978845608028654f * (x + 0.044715f * x * x * x); return x * __builtin_amdgcn_rcpf(1.0f + __expf(-2.0f * u)); }
__device__ __forceinline__ float sat8(float x) { return __builtin_amdgcn_fmed3f(x, -448.0f, 448.0f); }
__device__ __forceinline__ unsigned pk4_fp8(float a, float b, float c, float d) { int w = 0; w = __builtin_amdgcn_cvt_pk_fp8_f32(sat8(a), sat8(b), w, false); w = __builtin_amdgcn_cvt_pk_fp8_f32(sat8(c), sat8(d), w, true); return (unsigned)w; }
__device__ __forceinline__ f32x4 up4_fp8(unsigned w) { const f32x2 lo = __builtin_amdgcn_cvt_pk_f32_fp8((int)w, false), hi = __builtin_amdgcn_cvt_pk_f32_fp8((int)w, true); return (f32x4){lo[0], lo[1], hi[0], hi[1]}; }
__device__ __forceinline__ float silu_f(float x) { return x * __builtin_amdgcn_rcpf(1.0f + __expf(-x)); }

#define XB_TMO      128
#define XB_XCNT(j)  (256  + 64 * (j))
#define XB_XSUB(j)  (1280 + 64 * (j))
#define XB_XGEN(j)  (2304 + 64 * (j))
#define XB_TOP      3328
#define XB_TOPGEN   3392
#define XCD_BAR_WORDS 3456
#define XB_SPIN_CAP (1u << 18)
__device__ __forceinline__ unsigned xb_ld(unsigned* p)              { return __hip_atomic_load(p, __ATOMIC_RELAXED, __HIP_MEMORY_SCOPE_AGENT); }
__device__ __forceinline__ unsigned xb_add(unsigned* p, unsigned v) { return __hip_atomic_fetch_add(p, v, __ATOMIC_RELAXED, __HIP_MEMORY_SCOPE_AGENT); }
__device__ __forceinline__ unsigned xb_xcc_id() { return (unsigned)__builtin_amdgcn_s_getreg((3 << 11) | 20) & 0xFu; }
#define XB_SPIN(cond, bar) do { unsigned _sp = 0; while (cond) { __builtin_amdgcn_s_sleep(1); \
    if ((++_sp & 255u) == 0u) { if (xb_ld(&(bar)[XB_TMO])) break; if (_sp > XB_SPIN_CAP) { atomicAdd(&(bar)[XB_TMO], 1u); break; } } } } while (0)
struct XcdBarrier { unsigned* bar; unsigned x; volatile LAS unsigned* st; };
__device__ __forceinline__ XcdBarrier xcd_barrier_post(unsigned* bar, volatile LAS unsigned* st) {
    XcdBarrier b; b.bar = bar; b.x = xb_xcc_id(); b.st = st;
    if (threadIdx.x == 0) (void)xb_add(&bar[XB_XCNT(b.x)], 1u);
    return b;
}
__device__ __forceinline__ void xcd_barrier_complete(unsigned* bar, unsigned x, unsigned& nloc, unsigned& nx) {
    const unsigned G = gridDim.x * gridDim.y * gridDim.z;
    unsigned sum, cnt, mine, sp = 0u;
    for (;;) {
        sum = 0u; cnt = 0u; mine = 0u;
#pragma unroll
        for (unsigned j = 0; j < 16; ++j) { const unsigned c = xb_ld(&bar[XB_XCNT(j)]); sum += c; cnt += (c > 0u) ? 1u : 0u; mine = (j == x) ? c : mine; }
        if (sum == G) break;
        __builtin_amdgcn_s_sleep(1);
        if ((++sp & 255u) == 0u) { if (xb_ld(&bar[XB_TMO])) break; if (sp > XB_SPIN_CAP) { atomicAdd(&bar[XB_TMO], 1u); break; } }
    }
    nloc = mine > 0u ? mine : 1u; nx = cnt > 0u ? cnt : 1u;
}
__device__ __forceinline__ void xcd_barrier(const XcdBarrier& b) {
    asm volatile("s_waitcnt vmcnt(0)" ::: "memory");
    __syncthreads();
    if (threadIdx.x == 0) {
        unsigned* bar = b.bar;
        __builtin_amdgcn_s_waitcnt(0);
        unsigned nloc = b.st[0], nx = b.st[1];
        if (nloc == 0u) { xcd_barrier_complete(bar, b.x, nloc, nx); b.st[0] = nloc; b.st[1] = nx; }
        const unsigned old = xb_add(&bar[XB_XSUB(b.x)], 1u);
        const unsigned gen = old / nloc;
        if (old + 1u == (gen + 1u) * nloc) {
            __builtin_amdgcn_fence(__ATOMIC_RELEASE, "agent");
            asm volatile("s_waitcnt vmcnt(0)" ::: "memory");
            const unsigned og = xb_add(&bar[XB_TOP], 1u);
            const unsigned tg = og / nx;
            if (og + 1u == (tg + 1u) * nx) xb_add(&bar[XB_TOPGEN], 1u);
            else XB_SPIN(xb_ld(&bar[XB_TOPGEN]) == tg, bar);
            __builtin_amdgcn_fence(__ATOMIC_ACQUIRE, "agent");
            xb_add(&bar[XB_XGEN(b.x)], 1u);
            asm volatile("s_waitcnt vmcnt(0)" ::: "memory");
        } else {
            XB_SPIN(xb_ld(&bar[XB_XGEN(b.x)]) == gen, bar);
            __builtin_amdgcn_fence(__ATOMIC_ACQUIRE, "agent");
            asm volatile("s_waitcnt vmcnt(0)" ::: "memory");
        }
    }
    __syncthreads();
}

namespace pg8 {
constexpr int BM = 256, BK = 64, HALF = 128, HTB = HALF * BK * 2, NXCD = 8, WGM = 8;
__host__ __device__ __forceinline__ int lds_byte(int r, int c) { const int st = (r >> 4) * 2 + (c >> 5), rr = r & 15, cc = c & 31, ob = rr * 64 + cc * 2; return st * 1024 + (ob ^ (((ob >> 9) & 1) << 5)); }
__host__ __device__ __forceinline__ void stage_rc(int b, int& R, int& C) { const int st = b / 1024, sb = b % 1024, swz = sb ^ (((sb >> 9) & 1) << 5); R = (st >> 1) * 16 + swz / 64; C = (st & 1) * 32 + (swz % 64) / 2; }
__host__ __device__ __forceinline__ int perm32(int rho) { const int n = rho >> 4, i = rho & 15; return 8 * (i >> 2) + 4 * n + (i & 3); }
__device__ __forceinline__ unsigned cvt_pk_bf16(float lo, float hi) { unsigned r; asm volatile("v_cvt_pk_bf16_f32 %0, %1, %2" : "=v"(r) : "v"(lo), "v"(hi)); return r; }

struct Unit { const char* a; const char* b; int i0, i1, i2, i3; };

__device__ __forceinline__ void tile_order(int L, int nM, int nN, int& pm, int& pn) {
    const int nwg = nM * nN; int wgid = L;
    { const int q = nwg / NXCD, r = nwg % NXCD, xcd = wgid % NXCD, off = wgid / NXCD; wgid = (xcd < r ? xcd * (q + 1) : r * (q + 1) + (xcd - r) * q) + off; }
    const int nig = WGM * nN, gid = wgid / nig, fm = gid * WGM, gsz = (nM - fm) < WGM ? (nM - fm) : WGM;
    pm = fm + ((wgid % nig) % gsz); pn = (wgid % nig) / gsz;
}

typedef int i32x4m __attribute__((ext_vector_type(4)));
typedef int i32x8m __attribute__((ext_vector_type(8)));
__device__ __forceinline__ i32x8m cat8(bf16x8 a, bf16x8 b) { return __builtin_shufflevector(__builtin_bit_cast(i32x4m, a), __builtin_bit_cast(i32x4m, b), 0, 1, 2, 3, 4, 5, 6, 7); }
template <class Epi, class Sched, bool ALIGN_EPI = true, bool F8 = false, int SCALE_B = 127>
__device__ __forceinline__ void gemm_phase(LAS unsigned char* lds, const int K, const int ldb, const Sched& S, const Epi& E) {
    const int tid = threadIdx.x, wid = __builtin_amdgcn_readfirstlane(tid >> 6), lane = tid & 63, wr = wid >> 2, wc = wid & 3, fr = lane & 15, fq = lane >> 4;
    const int nt = K / BK;
    int sR[2], sC[2]; unsigned voffB[2];
#pragma unroll
    for (int i = 0; i < 2; ++i) { stage_rc(tid * 16 + i * 8192, sR[i], sC[i]); const int Rb = Epi::PERM ? ((sR[i] & ~31) + perm32(sR[i] & 31)) : sR[i]; voffB[i] = (unsigned)(Rb * ldb + sC[i]) * 2u; }
    const size_t kstep = (size_t)(BK * 2);
    const size_t hstepB = (size_t)HALF * ldb * 2;
    const unsigned ldsw = (unsigned)wid * 1024u;
    const int aoff = lds_byte(wr * 64 + fr, fq * 8), boff = lds_byte(wc * 32 + fr, fq * 8);
#define PG8_SA(b, h) (((b) * 2 + (h)) * HTB)
#define PG8_SB(b, h) ((4 + (b) * 2 + (h)) * HTB)
#define PG8_STAGE2(bufoff, gbase, v0, v1) do { \
        __builtin_amdgcn_global_load_lds((const unsigned*)((const char*)(gbase) + (v0)), (LAS unsigned*)(lds + (bufoff) + ldsw), 16, 0, 0); \
        __builtin_amdgcn_global_load_lds((const unsigned*)((const char*)(gbase) + (v1)), (LAS unsigned*)(lds + (bufoff) + ldsw + 8192), 16, 0, 0); } while (0)
#define PG8_STAGEB(bufoff, gbase) PG8_STAGE2(bufoff, gbase, voffB[0], voffB[1])
#define PG8_LDA(dst, b, h) do { _Pragma("unroll") for (int m = 0; m < 4; ++m) { if constexpr (F8) dst##8[m] = cat8(*(const LAS bf16x8*)(lds + PG8_SA(b, h) + aoff + m * 2048), *(const LAS bf16x8*)(lds + PG8_SA(b, h) + aoff + m * 2048 + 1024)); \
        else { _Pragma("unroll") for (int k = 0; k < 2; ++k) dst[m][k] = *(const LAS bf16x8*)(lds + PG8_SA(b, h) + aoff + m * 2048 + k * 1024); } } } while (0)
#define PG8_LDB(dst, b, h) do { _Pragma("unroll") for (int n = 0; n < 2; ++n) { if constexpr (F8) dst##8[n] = cat8(*(const LAS bf16x8*)(lds + PG8_SB(b, h) + boff + n * 2048), *(const LAS bf16x8*)(lds + PG8_SB(b, h) + boff + n * 2048 + 1024)); \
        else { _Pragma("unroll") for (int k = 0; k < 2; ++k) dst[n][k] = *(const LAS bf16x8*)(lds + PG8_SB(b, h) + boff + n * 2048 + k * 1024); } } } while (0)
#define PG8_MMA(ai, bj, At, Bt) do { __builtin_amdgcn_s_setprio(1); _Pragma("unroll") for (int m = 0; m < 4; ++m) _Pragma("unroll") for (int n = 0; n < 2; ++n) { \
        if constexpr (F8) asm volatile("v_mfma_scale_f32_16x16x128_f8f6f4 %0, %1, %2, %0, %3, %4 op_sel_hi:[0,0,0]" : "+v"(acc[ai][bj][m][n]) : "v"(Bt##8[n]), "v"(At##8[m]), "v"(scb), "v"(sca)); \
        else { _Pragma("unroll") for (int k = 0; k < 2; ++k) acc[ai][bj][m][n] = __builtin_amdgcn_mfma_f32_16x16x32_bf16(Bt[n][k], At[m][k], acc[ai][bj][m][n], 0, 0, 0); } } \
        __builtin_amdgcn_s_setprio(0); } while (0)
#define PG8_WAIT_V(n) asm volatile("s_waitcnt vmcnt(" #n ")" ::: "memory")
#define PG8_WAIT_L(n) asm volatile("s_waitcnt lgkmcnt(" #n ")" ::: "memory")
#define PG8_BAR __builtin_amdgcn_s_barrier()
#define PG8_SCHED __builtin_amdgcn_sched_barrier(0)
    Unit cur, nxt; int ui = 0;
    if (!S.next(0, cur)) return;
    f32x4 acc[2][2][4][2];
#pragma unroll
    for (int a = 0; a < 2; ++a)
#pragma unroll
        for (int b = 0; b < 2; ++b)
#pragma unroll
            for (int m = 0; m < 4; ++m)
#pragma unroll
                for (int n = 0; n < 2; ++n) acc[a][b][m][n] = (f32x4){0.f, 0.f, 0.f, 0.f};
    int scb = SCALE_B, sca = 127; asm volatile("" : "+v"(scb), "+v"(sca));
    bf16x8 At[4][2], B0[2][2], B1[2][2]; i32x8m At8[4], B08[2], B18[2];
    unsigned cv00 = S.aoff(cur, sR[0], sC[0]), cv01 = S.aoff(cur, sR[1], sC[1]), cv10 = S.aoff(cur, HALF + sR[0], sC[0]), cv11 = S.aoff(cur, HALF + sR[1], sC[1]);
    const char* cA = cur.a; const char* cB = cur.b;
    PG8_STAGEB(PG8_SB(0, 0), cB); PG8_STAGEB(PG8_SB(0, 1), cB + hstepB); PG8_STAGE2(PG8_SA(0, 0), cA, cv00, cv01); PG8_STAGE2(PG8_SA(0, 1), cA, cv10, cv11);
    if (wr == 1) PG8_BAR;
    PG8_WAIT_V(2); PG8_BAR;
    PG8_STAGEB(PG8_SB(1, 0), cB + kstep); PG8_STAGE2(PG8_SA(1, 0), cA + kstep, cv00, cv01); PG8_STAGEB(PG8_SB(1, 1), cB + hstepB + kstep);
    PG8_WAIT_V(6); PG8_BAR;
    for (;;) {
        const bool has_next = S.next(ui + 1, nxt);
        const char* nA = has_next ? nxt.a : cA; const char* nB = has_next ? nxt.b : cB;
        unsigned nv00 = cv00, nv01 = cv01, nv10 = cv10, nv11 = cv11;
        if (Sched::GATHER && has_next && nt < 6) { nv00 = S.aoff(nxt, sR[0], sC[0]); nv01 = S.aoff(nxt, sR[1], sC[1]); nv10 = S.aoff(nxt, HALF + sR[0], sC[0]); nv11 = S.aoff(nxt, HALF + sR[1], sC[1]); }
#pragma nounroll
        for (int t = 0; t < nt; t += 2) {
            const bool last = (t == nt - 2);
            const char* a1 = cA + (size_t)(t + 1) * kstep;
            const char* a2 = last ? nA : cA + (size_t)(t + 2) * kstep; const char* b2 = last ? nB : cB + (size_t)(t + 2) * kstep;
            const char* a3 = a2 + kstep; const char* b3 = b2 + kstep;
            const unsigned x00 = last ? nv00 : cv00, x01 = last ? nv01 : cv01, x10 = last ? nv10 : cv10, x11 = last ? nv11 : cv11;
            PG8_LDB(B0, 0, 0); PG8_LDB(B1, 0, 1); PG8_SCHED; PG8_LDA(At, 0, 0); PG8_STAGE2(PG8_SA(1, 1), a1, cv10, cv11);
            PG8_WAIT_V(8); PG8_WAIT_L(0); PG8_BAR; PG8_MMA(0, 0, At, B0); PG8_MMA(0, 1, At, B1); PG8_BAR; PG8_SCHED;
            PG8_LDA(At, 0, 1); PG8_STAGEB(PG8_SB(0, 0), b2); PG8_STAGEB(PG8_SB(0, 1), b2 + hstepB); PG8_STAGE2(PG8_SA(0, 0), a2, x00, x01);
            PG8_WAIT_V(8); PG8_WAIT_L(0); PG8_BAR; PG8_MMA(1, 0, At, B0); PG8_MMA(1, 1, At, B1); PG8_BAR; PG8_SCHED;
            PG8_LDB(B0, 1, 0); PG8_LDB(B1, 1, 1); PG8_SCHED; PG8_LDA(At, 1, 0); PG8_STAGE2(PG8_SA(0, 1), a2, x10, x11);
            PG8_WAIT_V(8); PG8_WAIT_L(0); PG8_BAR; PG8_MMA(0, 0, At, B0); PG8_MMA(0, 1, At, B1); PG8_BAR; PG8_SCHED;
            PG8_LDA(At, 1, 1); PG8_STAGEB(PG8_SB(1, 0), b3); PG8_STAGEB(PG8_SB(1, 1), b3 + hstepB); PG8_STAGE2(PG8_SA(1, 0), a3, x00, x01);
            PG8_WAIT_V(8); PG8_WAIT_L(0); PG8_BAR; PG8_MMA(1, 0, At, B0); PG8_MMA(1, 1, At, B1); PG8_BAR; PG8_SCHED;
            if (Sched::GATHER && has_next && nt >= 6 && t == nt - 6) { nv00 = S.aoff(nxt, sR[0], sC[0]); nv01 = S.aoff(nxt, sR[1], sC[1]); nv10 = S.aoff(nxt, HALF + sR[0], sC[0]); nv11 = S.aoff(nxt, HALF + sR[1], sC[1]); }
        }
        if constexpr (ALIGN_EPI) { if (wr == 0) PG8_BAR; }
        if constexpr (F8) asm volatile("s_nop 15\n\ts_nop 3" ::: "memory");
        E(acc, cur, wr, wc, fr, fq);
        if (!has_next) break;
#pragma unroll
        for (int a = 0; a < 2; ++a)
#pragma unroll
            for (int b = 0; b < 2; ++b)
#pragma unroll
                for (int m = 0; m < 4; ++m)
#pragma unroll
                    for (int n = 0; n < 2; ++n) acc[a][b][m][n] = (f32x4){0.f, 0.f, 0.f, 0.f};
        cur = nxt; cA = nA; cB = nB; cv00 = nv00; cv01 = nv01; cv10 = nv10; cv11 = nv11; ++ui;
        if constexpr (ALIGN_EPI) { if (wr == 1) PG8_BAR; }
    }
    PG8_WAIT_V(0);
    if constexpr (!ALIGN_EPI) { if (wr == 0) PG8_BAR; }
    PG8_BAR;
#undef PG8_SA
#undef PG8_SB
#undef PG8_STAGE2
#undef PG8_STAGEB
#undef PG8_LDA
#undef PG8_LDB
#undef PG8_MMA
#undef PG8_WAIT_V
#undef PG8_WAIT_L
#undef PG8_BAR
#undef PG8_SCHED
}
}
using pg8::Unit;
using pg8::cvt_pk_bf16;

struct Args { const float* in[27]; float* out; unsigned char* ws; int ph_lo, ph_hi; };
enum { I_X = 0, I_C, I_CTX, I_CCTX, I_ADAW, I_ADAB, I_LNMG, I_LNMB, I_LNFG, I_LNFB, I_WIN, I_SLNG, I_SLNB, I_SWS, I_SBS, I_WOUT, I_WQKV, I_SINK, I_WAO,
       I_RW, I_RB, I_MG, I_MU, I_MD, I_SG, I_SU, I_SD };

struct Frame {
    LAS unsigned char* lds;
    int tid, lane, wave, G, bid;
    unsigned char* ws;
};
__device__ __forceinline__ int modrow(int row) { return row < TC ? 2 : ((row - TC) >> 12); }
__device__ __forceinline__ const float* modp(const unsigned char* ws, int layer, int r, int chunk) { return (const float*)(ws + WS_MOD) + ((size_t)(layer * 3 + r) * 6 + chunk) * D; }

struct ConvJob { const float* src; bf16_t* dst; int K, N, mode; };
__device__ __forceinline__ int rope_pos(int d) { const int half = d >> 6, which = (d >> 5) & 1, f = d & 31; return 32 * (half * 2 + (f >> 4)) + 8 * ((f & 15) >> 2) + 4 * which + (f & 3); }
__device__ __forceinline__ void conv_item8(const float* __restrict__ src, int K, int N, int k0, int n0, unsigned char* dst, int mode, LAS float* scr, int lane) {
    f32x4 ld[16];
#pragma unroll
    for (int i = 0; i < 16; ++i) { const int kr = 8 * i + (lane >> 3), c4 = lane & 7; ld[i] = __builtin_nontemporal_load((const GAS f32x4*)(src + (size_t)(k0 + kr) * N + n0 + 4 * c4)); }
#pragma unroll
    for (int i = 0; i < 16; ++i) { const int kr = 8 * i + (lane >> 3), c4 = lane & 7;
        LAS float* s = scr + kr * 33 + 4 * c4; s[0] = ld[i][0]; s[1] = ld[i][1]; s[2] = ld[i][2]; s[3] = ld[i][3]; }
    LDS_WAIT(); asm volatile("" ::: "memory");
    const int c = lane & 15;
#pragma unroll
    for (int j = 0; j < 8; ++j) { const int nl = 4 * j + (lane >> 4), n = n0 + nl; const LAS float* s = scr + (8 * c) * 33 + nl;
        u32x2 o; o.x = pk4_fp8(32.f * s[0], 32.f * s[33], 32.f * s[2 * 33], 32.f * s[3 * 33]); o.y = pk4_fp8(32.f * s[4 * 33], 32.f * s[5 * 33], 32.f * s[6 * 33], 32.f * s[7 * 33]);
        const int row = mode == 0 ? n : (n >> 7) * 256 + (mode == 3 ? 128 : 0) + (n & 127);
        *(GAS u32x2*)(dst + (size_t)row * K + k0 + 8 * c) = o; }
    LDS_WAIT(); asm volatile("" ::: "memory");
}
__device__ __forceinline__ void conv_item(const float* __restrict__ src, int K, int N, int k0, int n0, bf16_t* dst, int mode, bf16_t* dst_v, LAS float* scr, int lane, bool f8 = false) {
    f32x4 ld[16];
#pragma unroll
    for (int i = 0; i < 16; ++i) { const int kr = 4 * i + (lane >> 4), c4 = lane & 15; ld[i] = __builtin_nontemporal_load((const GAS f32x4*)(src + (size_t)(k0 + kr) * N + n0 + 4 * c4)); }
#pragma unroll
    for (int i = 0; i < 16; ++i) { const int kr = 4 * i + (lane >> 4), c4 = lane & 15;
        LAS float* s = scr + kr * 65 + 4 * c4; s[0] = ld[i][0]; s[1] = ld[i][1]; s[2] = ld[i][2]; s[3] = ld[i][3]; }
    LDS_WAIT(); asm volatile("" ::: "memory");
    const int c = lane & 7;
#pragma unroll
    for (int j = 0; j < 8; ++j) { const int nl = 8 * j + (lane >> 3), n = n0 + nl; const LAS float* s = scr + (8 * c) * 65 + nl;
        if (f8) {
            u32x2 o; o.x = pk4_fp8(32.f * s[0], 32.f * s[65], 32.f * s[2 * 65], 32.f * s[3 * 65]); o.y = pk4_fp8(32.f * s[4 * 65], 32.f * s[5 * 65], 32.f * s[6 * 65], 32.f * s[7 * 65]);
            const int row = mode == 0 ? n : (n >> 7) * 256 + (mode == 3 ? 128 : 0) + (n & 127);
            *(GAS u32x2*)((unsigned char*)dst + (size_t)row * K + k0 + 8 * c) = o; continue; }
        u32x4 o; o.x = pk2(s[0], s[65]); o.y = pk2(s[2 * 65], s[3 * 65]); o.z = pk2(s[4 * 65], s[5 * 65]); o.w = pk2(s[6 * 65], s[7 * 65]);
        bf16_t* drow;
        if (mode == 0) drow = dst + (size_t)n * K;
        else if (mode == 1) { if (n < 2560) drow = dst + (size_t)((n & ~127) + rope_pos(n & 127)) * K; else drow = dst_v + (size_t)(n - 2560) * K; }
        else { const int ntile = n >> 7, r = n & 127; drow = dst + (size_t)(ntile * 256 + (mode == 3 ? 128 : 0) + r) * K; }
        *(GAS u32x4*)(drow + k0 + 8 * c) = o; }
    LDS_WAIT(); asm volatile("" ::: "memory");
}
namespace cv { constexpr int I_A = 32 * 48, I_B = 32 * 32, I_E = 256; constexpr int N0 = I_A, N1 = N0 + I_B, N2 = N1 + I_A, N3 = N2 + I_B, NG = N3 + 130 * I_E, NU = NG + 130 * I_E, ND = NU + 130 * I_E, HALFM = 65 * I_E; }
constexpr int CW_QHEAD = 2048;
static __device__ __forceinline__ void conv_impl(LAS unsigned char* lds, unsigned char* ws, const float* win, const float* wout, const float* wqkv, const float* wao, const float* mg, const float* mu, const float* md,
                                       const float* sg, const float* su, const float* sd, int it_lo, int it_hi, int gw, int NGW, unsigned* qhead, int quota) {
    using namespace cv;
    const int lane = threadIdx.x & 63, wave = threadIdx.x >> 6;
    LAS float* scr = (LAS float*)(lds + wave * 16896);
    int it0 = it_lo + gw; bool deferred = false;
    if (qhead) { deferred = true;
        if (quota >= 0) { unsigned d = 0u; if (lane == 0) d = __hip_atomic_fetch_add(qhead, (unsigned)quota, __ATOMIC_RELAXED, __HIP_MEMORY_SCOPE_AGENT);
            it0 = __builtin_amdgcn_readfirstlane((int)d); it_hi = it0 + quota; NGW = 1; }
        else { const unsigned h = __hip_atomic_load(qhead, __ATOMIC_RELAXED, __HIP_MEMORY_SCOPE_AGENT); it0 = (int)h + gw; }
        if (it_hi > 4 * HALFM) it_hi = 4 * HALFM; }
    for (;;) {
        if (it0 >= it_hi) break;
        int it = it0; it0 += NGW;
        if (deferred) it = it < HALFM ? NU + it : it < 2 * HALFM ? N3 + it : it < 3 * HALFM ? NG + it - HALFM : NU + it - 2 * HALFM;
        const float* src; bf16_t* dst; bf16_t* dstv = nullptr; int K, N, mode, r; bool f8 = false;
        if (it < N0) { r = it; src = win; dst = (bf16_t*)(ws + WS_WIN); K = 2048; N = 3072; mode = 0; }
        else if (it < N1) { r = it - N0; src = wout; dst = (bf16_t*)(ws + WS_WOUT); K = 2048; N = 2048; mode = 0; }
        else if (it < N2) { r = it - N1; src = wqkv; dst = (bf16_t*)(ws + WS_WQK); dstv = (bf16_t*)(ws + WS_WV); K = 2048; N = 3072; mode = 1; }
        else if (it < N3) { r = it - N2; src = wao; dst = (bf16_t*)(ws + WS_WAO); K = 2048; N = 2048; mode = 0; }
        else {
            int cls, q; if (it < NG) { cls = 0; q = it - N3; } else if (it < NU) { cls = 1; q = it - NG; } else { cls = 2; q = it - NU; }
            const int mat = q / I_E; r = q % I_E; const int layer = mat / 65, e = mat % 65;
            if (cls < 2) { K = 2048; N = 512; mode = 2 + cls;
                src = (e < 64) ? (cls == 0 ? mg : mu) + ((size_t)(layer * 64 + e)) * 2048 * 512 : (cls == 0 ? sg : su) + (size_t)layer * 2048 * 512;
                dst = (bf16_t*)(ws + WS_WGU + layer * WGU8_L + e * WGU8_E); f8 = true; }
            else { K = 512; N = 2048; mode = 0;
                src = (e < 64) ? md + ((size_t)(layer * 64 + e)) * 512 * 2048 : sd + (size_t)layer * 512 * 2048;
                dst = (bf16_t*)(ws + WS_WD + layer * WD8_L + e * WD8_E); f8 = true; }
        }
        if (f8) { const int nb = N / 32, kb = r / nb, nbi = r % nb; conv_item8(src, K, N, kb * 128, nbi * 32, (unsigned char*)dst, mode, scr, lane); }
        else { const int nb = N / 64, kb = r / nb, nbi = r % nb; conv_item(src, K, N, kb * 64, nbi * 64, dst, mode, dstv, scr, lane, false); }
    }
}
__device__ __forceinline__ void conv_range(const Frame& F, const Args& a, int it_lo, int it_hi) {
    conv_impl(F.lds, F.ws, a.in[I_WIN], a.in[I_WOUT], a.in[I_WQKV], a.in[I_WAO], a.in[I_MG], a.in[I_MU], a.in[I_MD], a.in[I_SG], a.in[I_SU], a.in[I_SD], it_lo, it_hi, F.bid * NWAVES + F.wave, F.G * NWAVES, nullptr, 0);
}
__device__ __forceinline__ void conv_pull(const Frame& F, const Args& a, int quota) {
    if (quota > 0) conv_impl(F.lds, F.ws, a.in[I_WIN], a.in[I_WOUT], a.in[I_WQKV], a.in[I_WAO], a.in[I_MG], a.in[I_MU], a.in[I_MD], a.in[I_SG], a.in[I_SU], a.in[I_SD], 0, 0, 0, 1, (unsigned*)(F.ws + WS_CTL) + CW_QHEAD, quota);
}
__device__ __forceinline__ void conv_cleanup(const Frame& F, const Args& a, int upto) {
    conv_impl(F.lds, F.ws, a.in[I_WIN], a.in[I_WOUT], a.in[I_WQKV], a.in[I_WAO], a.in[I_MG], a.in[I_MU], a.in[I_MD], a.in[I_SG], a.in[I_SU], a.in[I_SD], 0, upto, F.bid * NWAVES + F.wave, F.G * NWAVES, (unsigned*)(F.ws + WS_CTL) + CW_QHEAD, -1);
}
__device__ __forceinline__ void p0_mod(const Frame& F, const Args& a) {
    LAS float* sv = (LAS float*)F.lds;
    LAS float* red = (LAS float*)(F.lds + 32768);
    for (int i = F.tid; i < 3 * D; i += NTHREADS) { const int r = i / D, k = i % D; const float v = r < 2 ? a.in[I_C][r * D + k] : a.in[I_CCTX][k]; sv[i] = silu_f(v); }
    __syncthreads();
    float* mod = (float*)(F.ws + WS_MOD);
    for (int u = F.bid; u < 256; u += F.G) {
        const int layer = u >> 7, n0 = (u & 127) * 96;
        const float* W = a.in[I_ADAW] + (size_t)layer * D * 12288;
        const int kq = F.lane / 24, c4 = F.lane % 24; const bool act = F.lane < 48;
        f32x4 acc[3] = {{0.f, 0.f, 0.f, 0.f}, {0.f, 0.f, 0.f, 0.f}, {0.f, 0.f, 0.f, 0.f}};
        if (act) {
#pragma unroll 8
            for (int it = 0; it < 128; ++it) { const int k = F.wave * 256 + it * 2 + kq;
                const f32x4 w = __builtin_nontemporal_load((const GAS f32x4*)(W + (size_t)k * 12288 + n0 + 4 * c4));
#pragma unroll
                for (int r = 0; r < 3; ++r) acc[r] += w * sv[r * D + k]; } }
#pragma unroll
        for (int r = 0; r < 3; ++r)
#pragma unroll
            for (int j = 0; j < 4; ++j) { const float o = __shfl(acc[r][j], (F.lane + 24) & 63); if (F.lane < 24) red[(F.wave * 3 + r) * 96 + 4 * c4 + j] = acc[r][j] + o; }
        __syncthreads();
        if (F.tid < 288) { const int r = F.tid / 96, cidx = F.tid % 96; float s = 0.f;
#pragma unroll
            for (int w = 0; w < 8; ++w) s += red[(w * 3 + r) * 96 + cidx];
            mod[(size_t)(layer * 3 + r) * 12288 + n0 + cidx] = s + a.in[I_ADAB][layer * 12288 + n0 + cidx]; }
        __syncthreads();
    }
}
__device__ __forceinline__ void p0_tables(const Frame& F, const float* rwsrc) {
    bf16_t* wct = (bf16_t*)(F.ws + WS_WCT); bf16_t* t256 = (bf16_t*)(F.ws + WS_T256); f32x2* rope = (f32x2*)(F.ws + WS_ROPE);
    const int gt = F.bid * NTHREADS + F.tid, NGT = F.G * NTHREADS;
    for (int i = gt; i < 256 * 256; i += NGT) { const int m = i >> 8, c = i & 255, j = (m * c) & 255;
        const float cs = cospif((float)j * (1.0f / 128.0f)), sn = sinpif((float)j * (1.0f / 128.0f));
        wct[(2 * m) * 256 + c] = (bf16_t)f2bf(cs); wct[(2 * m + 1) * 256 + c] = (bf16_t)f2bf(-sn);
        t256[m * 512 + c] = (bf16_t)f2bf(cs); t256[m * 512 + 256 + c] = (bf16_t)f2bf(sn); }
    for (int i = gt; i < 2 * D * NEXP; i += NGT) { const int layer = i / (D * NEXP), k = (i / NEXP) % D, e = i % NEXP; const float w = rwsrc[i];
        const unsigned hi = f2bf(w); const float lo = w - __builtin_bit_cast(float, hi << 16);
        ((bf16_t*)(F.ws + WS_RWH))[(size_t)(layer * NEXP + e) * D + k] = (bf16_t)hi; ((bf16_t*)(F.ws + WS_RWL))[(size_t)(layer * NEXP + e) * D + k] = (bf16_t)f2bf(lo); }
    for (int i = gt; i < 64 * 32; i += NGT) { const int id = i >> 5, f = i & 31;
        const double inv = pow(10000.0, -(double)f / 32.0); const double ang = (double)id * (double)(float)inv;
        rope[i] = (f32x2){(float)cos(ang), (float)sin(ang)}; }
}

__device__ __forceinline__ void phase_modulate0(const Frame& F, const Args& a) {
    bf16_t* A0 = (bf16_t*)(F.ws + WS_A0);
    const int gw = F.bid * NWAVES + F.wave, NGW = F.G * NWAVES;
    for (int row = gw; row < T0; row += NGW) {
        const float* src = row < TC ? a.in[I_CTX] + (size_t)row * D : a.in[I_X] + (size_t)(row - TC) * D;
        const int r = modrow(row); const float* sh = modp(F.ws, 0, r, 0); const float* sc = modp(F.ws, 0, r, 1);
#pragma unroll
        for (int j = 0; j < 8; ++j) { const int c = 4 * F.lane + 256 * j;
            const f32x4 v = *(const GAS f32x4*)(src + c), s = *(const GAS f32x4*)(sc + c), h = *(const GAS f32x4*)(sh + c);
            const f32x4 o = v * (s + 1.0f) + h; u32x2 w; w.x = pk2(o[0], o[1]); w.y = pk2(o[2], o[3]);
            *(GAS u32x2*)(A0 + (size_t)row * D + c) = w; }
    }
}

__device__ __forceinline__ void phase_butterfly(const Frame& F) {
    LAS f32x2* tw = (LAS f32x2*)F.lds;
    for (int j = F.tid; j < 4096; j += NTHREADS) { const float x = (float)j * (1.0f / 2048.0f); tw[j] = (f32x2){cospif(x), sinpif(x)}; }
    __syncthreads();
    const bf16_t* Yt = (const bf16_t*)(F.ws + WS_YTL); bf16_t* Gt = (bf16_t*)(F.ws + WS_GT);
    for (int item = F.bid * NTHREADS + F.tid; item < 2 * 1024 * 64; item += F.G * NTHREADS) {
        const int lq = item & 63, n = (item >> 6) & 1023, b = item >> 16, l1 = 4 * lq;
        const bf16_t* yre = Yt + ((size_t)(b * 1024 + n) * 2 + 0) * 4096 + l1; const bf16_t* yim = yre + 4096;
        float are[16][4], aim[16][4];
#pragma unroll
        for (int l2 = 0; l2 < 16; ++l2) { const u32x2 p = *(const GAS u32x2*)(yre + 256 * l2), q = *(const GAS u32x2*)(yim + 256 * l2);
            are[l2][0] = bflo(p.x); are[l2][1] = bfhi(p.x); are[l2][2] = bflo(p.y); are[l2][3] = bfhi(p.y);
            aim[l2][0] = bflo(q.x); aim[l2][1] = bfhi(q.x); aim[l2][2] = bflo(q.y); aim[l2][3] = bfhi(q.y); }
        for (int r = 0; r < 16; ++r) {
            float sre[4] = {0.f, 0.f, 0.f, 0.f}, sim[4] = {0.f, 0.f, 0.f, 0.f};
#pragma unroll
            for (int l2 = 0; l2 < 16; ++l2) { const f32x2 cs = tw[((l2 * r) & 15) * 256];
#pragma unroll
                for (int e = 0; e < 4; ++e) { sre[e] += are[l2][e] * cs.x + aim[l2][e] * cs.y; sim[e] += aim[l2][e] * cs.x - are[l2][e] * cs.y; } }
            float gre[4], gim[4];
#pragma unroll
            for (int e = 0; e < 4; ++e) { const f32x2 cs = tw[((l1 + e) * r) & 4095]; gre[e] = sre[e] * cs.x + sim[e] * cs.y; gim[e] = sim[e] * cs.x - sre[e] * cs.y; }
            bf16_t* g = Gt + ((size_t)((b * 16 + r) * 1024 + n) * 2) * 256 + l1;
            u32x2 w; w.x = pk2(gre[0], gre[1]); w.y = pk2(gre[2], gre[3]); *(GAS u32x2*)g = w;
            w.x = pk2(gim[0], gim[1]); w.y = pk2(gim[2], gim[3]); *(GAS u32x2*)(g + 256) = w;
        }
    }
}

struct DenseSched {
    static constexpr bool GATHER = false;
    const char* A; const char* B; int lda, ldb, nM, nN, G, c;
    __device__ __forceinline__ bool next(int i, Unit& u) const { const int L = i * G + c; if (c >= G || L >= nM * nN) return false; int pm, pn; pg8::tile_order(L, nM, nN, pm, pn);
        u.a = A + (size_t)pm * 256 * lda * 2; u.b = B + (size_t)pn * 256 * ldb * 2; u.i0 = pm; u.i1 = pn; u.i2 = 0; u.i3 = 0; return true; }
    __device__ __forceinline__ unsigned aoff(const Unit&, int R, int C) const { return (unsigned)(R * lda + C) * 2u; }
};
struct EpiWin { static constexpr bool PERM = true; bf16_t* Z;
    __device__ __forceinline__ void operator()(const f32x4 (&acc)[2][2][4][2], const Unit& u, int wr, int wc, int fr, int fq) const {
        const int row0 = u.i0 * 256 + wr * 64 + fr, col0 = u.i1 * 256 + wc * 32 + 8 * fq; const bool act = u.i1 >= 4;
#pragma unroll
        for (int ai = 0; ai < 2; ++ai)
#pragma unroll
            for (int m = 0; m < 4; ++m) { bf16_t* rowp = Z + (size_t)(row0 + ai * 128 + m * 16) * 3072 + col0;
#pragma unroll
                for (int bj = 0; bj < 2; ++bj) { f32x4 v0 = acc[ai][bj][m][0], v1 = acc[ai][bj][m][1];
                    if (act) {
#pragma unroll
                        for (int j = 0; j < 4; ++j) { v0[j] = gelu_tanh(v0[j]); v1[j] = gelu_tanh(v1[j]); } }
                    u32x4 w; w.x = cvt_pk_bf16(v0[0], v0[1]); w.y = cvt_pk_bf16(v0[2], v0[3]); w.z = cvt_pk_bf16(v1[0], v1[1]); w.w = cvt_pk_bf16(v1[2], v1[3]);
                    *(GAS u32x4*)(rowp + bj * 128) = w; } }
    }
};
struct EpiResid { static constexpr bool PERM = true; bf16_t* X; const float* rx; const float* rctx; const unsigned char* ws; int layer, rowbase;
    __device__ __forceinline__ void operator()(const f32x4 (&acc)[2][2][4][2], const Unit& u, int wr, int wc, int fr, int fq) const {
        const int row0 = rowbase + u.i0 * 256 + wr * 64 + fr, col0 = u.i1 * 256 + wc * 32 + 8 * fq;
        const float* g1 = modp(ws, layer, modrow(rowbase + u.i0 * 256), 2) + col0;
        f32x4 gv[2][2];
#pragma unroll
        for (int bj = 0; bj < 2; ++bj)
#pragma unroll
            for (int n = 0; n < 2; ++n) gv[bj][n] = *(const GAS f32x4*)(g1 + bj * 128 + n * 4);
#pragma unroll
        for (int ai = 0; ai < 2; ++ai)
#pragma unroll
            for (int m = 0; m < 4; ++m) { const int row = row0 + ai * 128 + m * 16; bf16_t* op = X + (size_t)row * D + col0;
#pragma unroll
                for (int bj = 0; bj < 2; ++bj) { f32x4 r0, r1;
                    if (layer == 0) { const float* rp = (row < TC ? rctx + (size_t)row * D : rx + (size_t)(row - TC) * D) + col0 + bj * 128; r0 = *(const GAS f32x4*)rp; r1 = *(const GAS f32x4*)(rp + 4); }
                    else { const u32x4 p = *(const GAS u32x4*)(op + bj * 128); r0 = (f32x4){bflo(p.x), bfhi(p.x), bflo(p.y), bfhi(p.y)}; r1 = (f32x4){bflo(p.z), bfhi(p.z), bflo(p.w), bfhi(p.w)}; }
                    const f32x4 v0 = r0 * ALPHA + gv[bj][0] * acc[ai][bj][m][0], v1 = r1 * ALPHA + gv[bj][1] * acc[ai][bj][m][1];
                    u32x4 w; w.x = cvt_pk_bf16(v0[0], v0[1]); w.y = cvt_pk_bf16(v0[2], v0[3]); w.z = cvt_pk_bf16(v1[0], v1[1]); w.w = cvt_pk_bf16(v1[2], v1[3]);
                    *(GAS u32x4*)(op + bj * 128) = w; } }
    }
};
struct EpiBf16G { static constexpr bool PERM = true; bf16_t* O0; bf16_t* O1; int ldc0, ldc1; float sc0, sc1;
    __device__ __forceinline__ void operator()(const f32x4 (&acc)[2][2][4][2], const Unit& u, int wr, int wc, int fr, int fq) const {
        bf16_t* O = u.i3 ? O1 : O0; const int ldc = u.i3 ? ldc1 : ldc0; const float sc = u.i3 ? sc1 : sc0; const int rs = u.i1;
        const int r0 = wr * 64 + fr, col0 = u.i2 + wc * 32 + 8 * fq;
#pragma unroll
        for (int ai = 0; ai < 2; ++ai)
#pragma unroll
            for (int m = 0; m < 4; ++m) { bf16_t* rowp = O + (size_t)(u.i0 + rs * (r0 + ai * 128 + m * 16)) * ldc + col0;
#pragma unroll
                for (int bj = 0; bj < 2; ++bj) { const f32x4 v0 = acc[ai][bj][m][0] * sc, v1 = acc[ai][bj][m][1] * sc;
                    u32x4 w; w.x = cvt_pk_bf16(v0[0], v0[1]); w.y = cvt_pk_bf16(v0[2], v0[3]); w.z = cvt_pk_bf16(v1[0], v1[1]); w.w = cvt_pk_bf16(v1[2], v1[3]);
                    *(GAS u32x4*)(rowp + bj * 128) = w; } }
    }
};
struct EpiYs8 { static constexpr bool PERM = true; unsigned char* YS;
    __device__ __forceinline__ void operator()(const f32x4 (&acc)[2][2][4][2], const Unit& u, int wr, int wc, int fr, int fq) const {
        const int r0 = wr * 64 + fr, col0 = u.i2 + wc * 32 + 8 * fq;
#pragma unroll
        for (int ai = 0; ai < 2; ++ai)
#pragma unroll
            for (int m = 0; m < 4; ++m) { unsigned char* rowp = YS + (size_t)(u.i0 + r0 + ai * 128 + m * 16) * D + col0;
#pragma unroll
                for (int bj = 0; bj < 2; ++bj) { const f32x4 v0 = acc[ai][bj][m][0] * 16.0f, v1 = acc[ai][bj][m][1] * 16.0f;
                    u32x2 w; w.x = pk4_fp8(v0[0], v0[1], v0[2], v0[3]); w.y = pk4_fp8(v1[0], v1[1], v1[2], v1[3]);
                    *(GAS u32x2*)(rowp + bj * 128) = w; } }
    }
};
struct Dft1Sched { static constexpr bool GATHER = false; const unsigned char* ws; int G, c;
    __device__ __forceinline__ bool next(int i, Unit& u) const { const int L = i * G + c; if (L >= 272) return false;
        int bg, mt, ntile, isctx; if (L < 256) { bg = L >> 5; mt = (L >> 4) & 1; ntile = L & 15; isctx = 0; } else { const int v = L - 256; bg = v >> 1; mt = v & 1; ntile = 0; isctx = 1; }
        const int b = bg >> 2, g = bg & 3, rowbase = isctx ? b * CTXL : TC + b * SEQ;
        u.a = (const char*)(ws + WS_WCT) + (size_t)mt * 256 * 256 * 2; u.b = (const char*)(ws + WS_Z) + ((size_t)(rowbase + ntile * 256) * 3072 + g * 256) * 2;
        u.i0 = bg * 512 + mt * 256; u.i1 = 1; u.i2 = ntile * 256; u.i3 = isctx; return true; }
    __device__ __forceinline__ unsigned aoff(const Unit&, int R, int C) const { return (unsigned)(R * 256 + C) * 2u; }
};
struct Dft2Sched { static constexpr bool GATHER = false; const unsigned char* ws; int G, c;
    __device__ __forceinline__ bool next(int i, Unit& u) const { const int L = i * G + c; if (L >= 136) return false;
        u.a = (const char*)(ws + WS_T256); u.i2 = (L & 3) * 256;
        if (L < 128) { const int b = L >> 6, r = (L >> 2) & 15, nt = L & 3; u.b = (const char*)(ws + WS_GT) + ((size_t)((b * 16 + r) * 1024 + nt * 256) * 512) * 2; u.i0 = TC + b * SEQ + r; u.i1 = 16; u.i3 = 0; }
        else { const int v = L - 128, b = v >> 2, nt = v & 3; u.b = (const char*)(ws + WS_YTC) + ((size_t)(b * 1024 + nt * 256) * 512) * 2; u.i0 = b * CTXL; u.i1 = 1; u.i3 = 1; }
        return true; }
    __device__ __forceinline__ unsigned aoff(const Unit&, int R, int C) const { return (unsigned)(R * 512 + C) * 2u; }
};
struct QkvSched { static constexpr bool GATHER = false; const unsigned char* ws; int G, c;
    __device__ __forceinline__ bool next(int i, Unit& u) const { const int L = i * G + c; if (L >= 392) return false;
        const char* A0 = (const char*)(ws + WS_A0);
        if (L < 324) { int pm, pn; if (L < 320) { pg8::tile_order(L, 32, 10, pm, pn); pm += 2; } else { pm = (L - 320) >> 1; pn = 8 + ((L - 320) & 1); }
            u.a = A0 + (size_t)pm * 256 * D * 2; u.b = (const char*)(ws + WS_WQK) + (size_t)pn * 256 * D * 2; u.i0 = pm * 256; u.i1 = pn; u.i2 = 0; u.i3 = 0; }
        else { const int v = L - 324, mt = v & 1, ntile = v >> 1;
            u.a = (const char*)(ws + WS_WV) + (size_t)mt * 256 * D * 2; u.b = A0 + (size_t)ntile * 256 * D * 2; u.i0 = mt * 256; u.i1 = ntile; u.i2 = 1; u.i3 = 0; }
        return true; }
    __device__ __forceinline__ unsigned aoff(const Unit&, int R, int C) const { return (unsigned)(R * D + C) * 2u; }
};
struct EpiQkv { static constexpr bool PERM = true; bf16_t* QK; bf16_t* VT; const f32x2* rope;
    __device__ __forceinline__ void operator()(const f32x4 (&acc)[2][2][4][2], const Unit& u, int wr, int wc, int fr, int fq) const {
        const int r0 = u.i0 + wr * 64 + fr;
        if (u.i2) {
            const int col0 = u.i1 * 256 + wc * 32 + 8 * fq;
#pragma unroll
            for (int ai = 0; ai < 2; ++ai)
#pragma unroll
                for (int m = 0; m < 4; ++m) { bf16_t* rowp = VT + (size_t)(r0 + ai * 128 + m * 16) * T0 + col0;
#pragma unroll
                    for (int bj = 0; bj < 2; ++bj) { const f32x4 v0 = acc[ai][bj][m][0], v1 = acc[ai][bj][m][1];
                        u32x4 w; w.x = cvt_pk_bf16(v0[0], v0[1]); w.y = cvt_pk_bf16(v0[2], v0[3]); w.z = cvt_pk_bf16(v1[0], v1[1]); w.w = cvt_pk_bf16(v1[2], v1[3]);
                        *(GAS u32x4*)(rowp + bj * 128) = w; } }
            return; }
        const int col0 = u.i1 * 256 + wc * 32 + 8 * fq; const float qs = u.i1 < 8 ? QSCALE : 1.0f; const bool dorope = u.i0 >= TC;
        const int half = wc >> 1, f0 = (wc & 1) * 16 + fq * 4;
#pragma unroll
        for (int ai = 0; ai < 2; ++ai)
#pragma unroll
            for (int m = 0; m < 4; ++m) { const int row = r0 + ai * 128 + m * 16; bf16_t* rowp = QK + (size_t)row * 2560 + col0;
                f32x4 cs0 = {1.f, 0.f, 1.f, 0.f}, cs1 = {1.f, 0.f, 1.f, 0.f};
                if (dorope) { const int s = (row - TC) & (SEQ - 1), id = half ? (s & 63) : (s >> 6); const GAS f32x4* rp = (const GAS f32x4*)(rope + id * 32 + f0); cs0 = rp[0]; cs1 = rp[1]; }
#pragma unroll
                for (int bj = 0; bj < 2; ++bj) { const f32x4 x1 = acc[ai][bj][m][0], x2 = acc[ai][bj][m][1]; f32x4 o1, o2;
                    o1[0] = x1[0] * cs0[0] - x2[0] * cs0[1]; o2[0] = x2[0] * cs0[0] + x1[0] * cs0[1];
                    o1[1] = x1[1] * cs0[2] - x2[1] * cs0[3]; o2[1] = x2[1] * cs0[2] + x1[1] * cs0[3];
                    o1[2] = x1[2] * cs1[0] - x2[2] * cs1[1]; o2[2] = x2[2] * cs1[0] + x1[2] * cs1[1];
                    o1[3] = x1[3] * cs1[2] - x2[3] * cs1[3]; o2[3] = x2[3] * cs1[2] + x1[3] * cs1[3];
                    o1 = o1 * qs; o2 = o2 * qs;
                    u32x4 w; w.x = cvt_pk_bf16(o1[0], o1[1]); w.y = cvt_pk_bf16(o1[2], o1[3]); w.z = cvt_pk_bf16(o2[0], o2[1]); w.w = cvt_pk_bf16(o2[2], o2[3]);
                    *(GAS u32x4*)(rowp + bj * 128) = w; } }
    }
};
typedef int i32x4 __attribute__((ext_vector_type(4)));
__device__ __forceinline__ void moe_tables(const Frame& F, int NT, int G, bool spare) {
    LAS int* tb = (LAS int*)(F.lds + MISC_OFF);
    LAS i32x4* ut = (LAS i32x4*)(F.lds + MISC_OFF + 1152);
    if (F.tid == 0) { const int* st = (const int*)(F.ws + WS_EXPT); const int* cn = st + 128; int cc = 0;
        for (int e = 0; e < NE1; ++e) { const int t = (cn[e] + 255) >> 8; tb[e] = cc; tb[66 + e] = t; tb[132 + e] = st[e]; cc += t * NT; }
        tb[65] = cc;
        int geff = G, c = (G % 8 == 0) ? (F.bid % 8) * (G / 8) + F.bid / 8 : F.bid, isconv = 0;
        if (spare && G == 256 && cc > 0) { const int rounds = (cc + G - 1) / G; geff = (cc + rounds - 1) / rounds; const int d = G - geff, x = F.bid & 7, li = F.bid >> 3;
            const int dx = d / 8 + (x < d % 8 ? 1 : 0); isconv = li >= 32 - dx; c = x * 32 - (x * (d / 8) + (x < d % 8 ? x : d % 8)) + li; }
        tb[202] = isconv; tb[200] = geff; tb[201] = c; }
    __syncthreads();
    if (F.tid < 32) { const int geff = tb[200], c = tb[201]; const int L = F.tid * geff + c; i32x4 v = {0, 0, 0, 0};
        if (!tb[202] && L < tb[65]) { int e = 0; while (L >= tb[e + 1]) ++e;
            const int rem = L - tb[e], t = tb[66 + e], mt = rem % t, nt = rem / t; v = (i32x4){e, tb[132 + e] + mt * 256, nt, 1}; }
        ut[F.tid] = v; }
    __syncthreads();
}
__device__ __forceinline__ bool moe_short(const Frame& F) { const LAS int* tb = (const LAS int*)(F.lds + MISC_OFF); const int total = tb[65], geff = tb[200], c = tb[201]; const int mx = (total + geff - 1) / geff; const int mine = total > c ? (total - c - 1) / geff + 1 : 0; return !tb[202] && mine < mx; }
__device__ __forceinline__ bool moe_conv(const Frame& F) { return ((const LAS int*)(F.lds + MISC_OFF))[202] != 0; }
struct MoeSched { static constexpr bool GATHER = true;
    const unsigned char* ws; LAS i32x4* ut; const int* slot_tok; int layer;
    __device__ __forceinline__ bool next(int i, Unit& u) const { if (i >= 32) return false; const i32x4 v = ut[i]; if (!v[3]) return false;
        u.a = (const char*)(ws + WS_A0); u.b = (const char*)(ws + WS_WGU) + (size_t)layer * WGU8_L + (size_t)v[0] * WGU8_E + (size_t)v[2] * 256 * D;
        u.i0 = v[1]; u.i1 = v[2]; u.i2 = v[0]; u.i3 = 0; return true; }
    __device__ __forceinline__ unsigned aoff(const Unit& u, int R, int C) const { return (unsigned)(slot_tok[u.i0 + R] * (D / 2) + C) * 2u; }
};
struct EpiGateUp { static constexpr bool PERM = true; bf16_t* ACT;
    __device__ __forceinline__ void operator()(const f32x4 (&acc)[2][2][4][2], const Unit& u, int wr, int wc, int fr, int fq) const {
        const int r0 = u.i0 + wr * 64 + fr, col0 = u.i1 * 128 + wc * 32 + 8 * fq;
#pragma unroll
        for (int ai = 0; ai < 2; ++ai)
#pragma unroll
            for (int m = 0; m < 4; ++m) { f32x4 h0, h1;
#pragma unroll
                for (int j = 0; j < 4; ++j) { h0[j] = silu_f(acc[ai][0][m][0][j]) * acc[ai][1][m][0][j]; h1[j] = silu_f(acc[ai][0][m][1][j]) * acc[ai][1][m][1][j]; }
                u32x2 w; w.x = pk4_fp8(h0[0], h0[1], h0[2], h0[3]); w.y = pk4_fp8(h1[0], h1[1], h1[2], h1[3]);
                *(GAS u32x2*)((unsigned char*)ACT + (size_t)(r0 + ai * 128 + m * 16) * EDIM + col0) = w; }
    }
};
struct MoeDownSched { static constexpr bool GATHER = false; const unsigned char* ws; LAS i32x4* ut; int layer;
    __device__ __forceinline__ bool next(int i, Unit& u) const { if (i >= 32) return false; const i32x4 v = ut[i]; if (!v[3]) return false;
        u.a = (const char*)(ws + WS_ACT) + (size_t)v[1] * EDIM; u.b = (const char*)(ws + WS_WD) + (size_t)layer * WD8_L + (size_t)v[0] * WD8_E + (size_t)v[2] * 256 * EDIM;
        u.i0 = v[1]; u.i1 = 1; u.i2 = v[2] * 256; u.i3 = 0; return true; }
    __device__ __forceinline__ unsigned aoff(const Unit&, int R, int C) const { return (unsigned)(R * (EDIM / 2) + C) * 2u; }
};

__device__ __forceinline__ void phase_sgu(const Frame& F, const Args& a) {
    LAS bf16_t* wA = (LAS bf16_t*)F.lds;
    LAS bf16_t* vT = (LAS bf16_t*)(F.lds + 34816);
    const bf16_t* Z = (const bf16_t*)(F.ws + WS_Z); bf16_t* MIX = (bf16_t*)(F.ws + WS_MIX);
    const int fr = F.lane & 15, fq = F.lane >> 4;
    for (int rnd = 0;; ++rnd) { const int unit = (F.G != 256) ? F.bid + rnd * F.G : rnd == 0 ? F.bid : (rnd == 1 && F.bid >= 16 && F.bid < 32) ? 256 + F.bid - 16 : (1 << 20); if (unit >= 272) break;
        const int chunk = unit >> 2, g = unit & 3, r0 = chunk * 128;
        const float* wsrc = a.in[I_SWS] + (size_t)g * 128 * 128;
#pragma unroll
        for (int i = 0; i < 8; ++i) { const int idx = F.tid + 512 * i, p = idx >> 5, q4 = idx & 31; const f32x4 v = *(const GAS f32x4*)(wsrc + p * 128 + 4 * q4);
            u32x2 w; w.x = pk2(v[0], v[1]); w.y = pk2(v[2], v[3]); *(LAS u32x2*)(wA + p * 136 + 4 * q4) = w; }
        { const int rg = F.tid >> 5, c8 = F.tid & 31; const int cb = g * 256 + 8 * c8;
          const f32x4 lg0 = *(const GAS f32x4*)(a.in[I_SLNG] + cb), lg1 = *(const GAS f32x4*)(a.in[I_SLNG] + cb + 4), lb0 = *(const GAS f32x4*)(a.in[I_SLNB] + cb), lb1 = *(const GAS f32x4*)(a.in[I_SLNB] + cb + 4);
#pragma unroll 2
          for (int pass = 0; pass < 8; ++pass) { const int q = pass * 16 + rg;
            const u32x4 raw = *(const GAS u32x4*)(Z + (size_t)(r0 + q) * 3072 + 2048 + cb);
            float x[8] = {bflo(raw.x), bfhi(raw.x), bflo(raw.y), bfhi(raw.y), bflo(raw.z), bfhi(raw.z), bflo(raw.w), bfhi(raw.w)};
            float s = 0.f;
#pragma unroll
            for (int i = 0; i < 8; ++i) s += x[i];
#pragma unroll
            for (int o = 1; o < 32; o <<= 1) s += __shfl_xor(s, o);
            const float mean = s * (1.0f / 256.0f); float ss = 0.f;
#pragma unroll
            for (int i = 0; i < 8; ++i) { x[i] -= mean; ss += x[i] * x[i]; }
#pragma unroll
            for (int o = 1; o < 32; o <<= 1) ss += __shfl_xor(ss, o);
            const float rstd = rsqrtf(ss * (1.0f / 256.0f) + LN_EPS);
#pragma unroll
            for (int i = 0; i < 8; ++i) { const float gg = i < 4 ? lg0[i & 3] : lg1[i & 3], bb = i < 4 ? lb0[i & 3] : lb1[i & 3];
                vT[(8 * c8 + i) * 136 + (q ^ ((c8 & 15) << 3))] = (bf16_t)f2bf(x[i] * rstd * gg + bb); } } }
        __syncthreads();
        const int pm = F.wave & 1, cn = F.wave >> 1;
        f32x4 acc[4][4];
#pragma unroll
        for (int m = 0; m < 4; ++m)
#pragma unroll
            for (int n = 0; n < 4; ++n) acc[m][n] = (f32x4){0.f, 0.f, 0.f, 0.f};
#pragma unroll
        for (int kk = 0; kk < 4; ++kk) { bf16x8 am[4], bn[4];
#pragma unroll
            for (int m = 0; m < 4; ++m) am[m] = *(const LAS bf16x8*)(wA + (64 * pm + 16 * m + fr) * 136 + 32 * kk + 8 * fq);
#pragma unroll
            for (int n = 0; n < 4; ++n) { const int cr = 64 * cn + 16 * n + fr; bn[n] = *(const LAS bf16x8*)(vT + cr * 136 + ((32 * kk + 8 * fq) ^ (((cr >> 3) & 15) << 3))); }
#pragma unroll
            for (int m = 0; m < 4; ++m)
#pragma unroll
                for (int n = 0; n < 4; ++n) acc[m][n] = __builtin_amdgcn_mfma_f32_16x16x32_bf16(bn[n], am[m], acc[m][n], 0, 0, 0); }
#pragma unroll
        for (int m = 0; m < 4; ++m) { const int p = 64 * pm + 16 * m + fr, row = r0 + p; const float bias = a.in[I_SBS][g * 128 + p];
#pragma unroll
            for (int n = 0; n < 4; ++n) { const int c = g * 256 + 64 * cn + 16 * n + 4 * fq;
                const u32x2 uu = *(const GAS u32x2*)(Z + (size_t)row * 3072 + 1024 + c);
                const float s0 = bflo(uu.x) * (acc[m][n][0] + bias), s1 = bfhi(uu.x) * (acc[m][n][1] + bias), s2 = bflo(uu.y) * (acc[m][n][2] + bias), s3 = bfhi(uu.y) * (acc[m][n][3] + bias);
                u32x2 w; w.x = pk2(s0, s1); w.y = pk2(s2, s3); *(GAS u32x2*)(MIX + (size_t)row * D + 1024 + c) = w; } }
        __syncthreads();
    }
}

constexpr int HB_LD = 2056;
__device__ __forceinline__ void phase_ln_router(const Frame& F, const Args& a, int layer) {
    LAS bf16_t* hb = (LAS bf16_t*)F.lds;
    LAS float* part = (LAS float*)F.lds;
    LAS int* histw = (LAS int*)(F.lds + 141312);
    bf16_t* X = (bf16_t*)(F.ws + WS_X); bf16_t* A0 = (bf16_t*)(F.ws + WS_A0);
    int* SE = (int*)(F.ws + WS_SELE); float* SW = (float*)(F.ws + WS_SELW); int* HIST = (int*)(F.ws + WS_HIST);
    const int tok0 = layer ? TC : 0, TPB = layer ? 32 : 34;
    const float* lng = a.in[I_LNMG] + layer * D; const float* lnb = a.in[I_LNMB] + layer * D;
    const bf16_t* rwh = (const bf16_t*)(F.ws + WS_RWH) + (size_t)layer * NEXP * D; const bf16_t* rwl = (const bf16_t*)(F.ws + WS_RWL) + (size_t)layer * NEXP * D;
    const float rbias = a.in[I_RB][layer * NEXP + F.lane];
    const int fr = F.lane & 15, fq = F.lane >> 4;
    for (int vb = F.bid; vb < 256; vb += F.G) {
        const int rb = tok0 + vb * TPB; int mycnt = 0;
        f32x4 psc[8], psh[8]; int rcur = -1;
        for (int j = F.wave; j < TPB; j += 8) { const int row = rb + j; bf16_t* xr = X + (size_t)row * D;
            f32x4 v[8]; float s = 0.f;
#pragma unroll
            for (int i = 0; i < 8; ++i) { const u32x2 p = *(const GAS u32x2*)(xr + 4 * F.lane + 256 * i); v[i] = (f32x4){bflo(p.x), bfhi(p.x), bflo(p.y), bfhi(p.y)}; s += (v[i][0] + v[i][1]) + (v[i][2] + v[i][3]); }
            const int r = modrow(row);
            if (r != rcur) { rcur = r; const float* sh2 = modp(F.ws, layer, r, 3); const float* sc2 = modp(F.ws, layer, r, 4);
#pragma unroll
                for (int i = 0; i < 8; ++i) { const int c = 4 * F.lane + 256 * i; psc[i] = *(const GAS f32x4*)(sc2 + c) + 1.0f; psh[i] = *(const GAS f32x4*)(sh2 + c); } }
            const float mean = wave_sum(s) * (1.0f / D); float ss = 0.f;
#pragma unroll
            for (int i = 0; i < 8; ++i) { v[i] = v[i] - mean; ss += (v[i][0] * v[i][0] + v[i][1] * v[i][1]) + (v[i][2] * v[i][2] + v[i][3] * v[i][3]); }
            const float rstd = rsqrtf(wave_sum(ss) * (1.0f / D) + LN_EPS);
#pragma unroll
            for (int i = 0; i < 8; ++i) { const int c = 4 * F.lane + 256 * i;
                const f32x4 lat = v[i] * rstd * *(const GAS f32x4*)(lng + c) + *(const GAS f32x4*)(lnb + c);
                { u32x2 wl; wl.x = pk2(lat[0], lat[1]); wl.y = pk2(lat[2], lat[3]); *(GAS u32x2*)(xr + c) = wl; }
                const f32x4 h = lat * psc[i] + psh[i];
                u32x2 w; w.x = pk2(h[0], h[1]); w.y = pk2(h[2], h[3]); *(GAS unsigned*)((unsigned char*)A0 + (size_t)row * D + c) = pk4_fp8(h[0], h[1], h[2], h[3]);
                *(LAS u32x2*)(hb + j * HB_LD + c) = w; } }
        __syncthreads();
        f32x4 acc[3][4];
#pragma unroll
        for (int mt = 0; mt < 3; ++mt)
#pragma unroll
            for (int nt = 0; nt < 4; ++nt) acc[mt][nt] = (f32x4){0.f, 0.f, 0.f, 0.f};
        { int arow[3];
#pragma unroll
          for (int mt = 0; mt < 3; ++mt) { const int rr = 16 * mt + fr; arow[mt] = (rr < TPB ? rr : TPB - 1) * HB_LD; }
#pragma unroll 2
          for (int kk = 0; kk < 8; ++kk) { const int k0 = F.wave * 256 + 32 * kk + 8 * fq;
              bf16x8 bh[4], bl[4], af[3];
#pragma unroll
              for (int nt = 0; nt < 4; ++nt) { bh[nt] = *(const GAS bf16x8*)(rwh + (size_t)(16 * nt + fr) * D + k0); bl[nt] = *(const GAS bf16x8*)(rwl + (size_t)(16 * nt + fr) * D + k0); }
#pragma unroll
              for (int mt = 0; mt < 3; ++mt) af[mt] = *(const LAS bf16x8*)(hb + arow[mt] + k0);
#pragma unroll
              for (int mt = 0; mt < 3; ++mt)
#pragma unroll
                  for (int nt = 0; nt < 4; ++nt) { acc[mt][nt] = __builtin_amdgcn_mfma_f32_16x16x32_bf16(af[mt], bh[nt], acc[mt][nt], 0, 0, 0);
                      acc[mt][nt] = __builtin_amdgcn_mfma_f32_16x16x32_bf16(af[mt], bl[nt], acc[mt][nt], 0, 0, 0); } } }
        __syncthreads();
#pragma unroll
        for (int mt = 0; mt < 3; ++mt)
#pragma unroll
            for (int nt = 0; nt < 4; ++nt)
#pragma unroll
                for (int j = 0; j < 4; ++j) part[(F.wave * 48 + 16 * mt + 4 * fq + j) * 64 + 16 * nt + fr] = acc[mt][nt][j];
        __syncthreads();
        for (int j = F.wave; j < TPB; j += 8) { const int row = rb + j; float logit = 0.f;
#pragma unroll
            for (int w = 0; w < 8; ++w) logit += part[(w * 48 + j) * 64 + F.lane];
            const float sg = 1.0f / (1.0f + expf(-logit)), bsd = sg + rbias;
            float m1 = bsd;
#pragma unroll
            for (int o = 1; o < 8; o <<= 1) m1 = fmaxf(m1, __shfl_xor(m1, o));
            int idx = (bsd == m1) ? (F.lane & 7) : 8;
#pragma unroll
            for (int o = 1; o < 8; o <<= 1) idx = min(idx, __shfl_xor(idx, o));
            float m2 = ((F.lane & 7) == idx) ? -INFINITY : bsd;
#pragma unroll
            for (int o = 1; o < 8; o <<= 1) m2 = fmaxf(m2, __shfl_xor(m2, o));
            const float gs = m1 + m2; const int mygrp = F.lane >> 3; int grank = 0;
#pragma unroll
            for (int gg = 0; gg < 8; ++gg) { const float og = __builtin_bit_cast(float, __builtin_amdgcn_readlane(__builtin_bit_cast(int, gs), gg * 8)); grank += (og > gs || (og == gs && gg < mygrp)) ? 1 : 0; }
            const bool gsel = grank < 4; const float cand = gsel ? bsd : -INFINITY; int rank = 0;
#pragma unroll 8
            for (int e2 = 0; e2 < 64; ++e2) { const float ov = __builtin_bit_cast(float, __builtin_amdgcn_readlane(__builtin_bit_cast(int, cand), e2)); rank += (ov > cand || (ov == cand && e2 < F.lane)) ? 1 : 0; }
            const bool sel = gsel && rank < TOPK;
            const float wsum = wave_sum(sel ? sg : 0.f);
            if (sel) { SE[row * 8 + rank] = F.lane; SW[row * 8 + rank] = sg / wsum * 2.5f; mycnt += 1; } }
        histw[F.wave * 64 + F.lane] = mycnt;
        __syncthreads();
        if (F.tid < 64) { int s = 0;
#pragma unroll
            for (int w = 0; w < 8; ++w) s += histw[w * 64 + F.tid];
            HIST[vb * 64 + F.tid] = s; }
        __syncthreads();
    }
}

__device__ __forceinline__ void phase_scatter(const Frame& F, int layer) {
    LAS int* pall = (LAS int*)F.lds;
    LAS int* plo = pall + 512;
    LAS int* st_l = plo + 512;
    LAS int* sel_l = st_l + 64;
    LAS int* misc = sel_l + 288;
    const int* HIST = (const int*)(F.ws + WS_HIST); const int* SE = (const int*)(F.ws + WS_SELE);
    int* EXPT = (int*)(F.ws + WS_EXPT); int* SLOT_TOK = (int*)(F.ws + WS_SLOTTOK); int* TOK_SLOT = (int*)(F.ws + WS_TOKSLOT);
    const int tok0 = layer ? TC : 0, TPB = layer ? 32 : 34, ntok = T0 - tok0;
    for (int vb = F.bid; vb < 256; vb += F.G) {
        int all = 0, lo = 0;
        for (int b = F.wave * 32; b < F.wave * 32 + 32; ++b) { const int h = HIST[b * 64 + F.lane]; all += h; lo += (b < vb) ? h : 0; }
        pall[F.wave * 64 + F.lane] = all; plo[F.wave * 64 + F.lane] = lo;
        const int rb = tok0 + vb * TPB;
        for (int i = F.tid; i < TPB * 8; i += NTHREADS) sel_l[i] = SE[rb * 8 + i];
        __syncthreads();
        if (F.wave == 0) { int tot = 0, base = 0;
#pragma unroll
            for (int w = 0; w < 8; ++w) { tot += pall[w * 64 + F.lane]; base += plo[w * 64 + F.lane]; }
            const int padded = (tot + 255) & ~255; int incl = padded;
#pragma unroll
            for (int o = 1; o < 64; o <<= 1) { const int t = __shfl_up(incl, o); if (F.lane >= o) incl += t; }
            const int start = incl - padded, total_pad = __shfl(incl, 63);
            st_l[F.lane] = start + base; if (F.lane == 0) misc[0] = total_pad;
            if (vb == 0) { EXPT[F.lane] = start; EXPT[128 + F.lane] = tot; if (F.lane == 0) { EXPT[64] = total_pad; EXPT[128 + 64] = ntok; }
                for (int s = tot; s < padded; ++s) SLOT_TOK[start + s] = tok0; } }
        __syncthreads();
        if (F.tid < TPB * 8) { const int e = sel_l[F.tid]; int rank = 0;
            for (int p = 0; p < F.tid; ++p) rank += (sel_l[p] == e) ? 1 : 0;
            const int slot = st_l[e] + rank, t = rb + (F.tid >> 3);
            SLOT_TOK[slot] = t; TOK_SLOT[t * 8 + (F.tid & 7)] = slot; }
        if (F.tid < TPB) SLOT_TOK[misc[0] + (rb - tok0) + F.tid] = rb + F.tid;
        __syncthreads();
    }
}

__device__ __forceinline__ void phase_combine(const Frame& F, const Args& a, int layer) {
    bf16_t* X = (bf16_t*)(F.ws + WS_X); bf16_t* A0 = (bf16_t*)(F.ws + WS_A0); const unsigned char* YS = F.ws + WS_YS;
    const int* TOK_SLOT = (const int*)(F.ws + WS_TOKSLOT); const float* SW = (const float*)(F.ws + WS_SELW); const int* EXPT = (const int*)(F.ws + WS_EXPT);
    const int tok0 = layer ? TC : 0, TPB = layer ? 32 : 34; const int start64 = EXPT[64];
    LAS float* P = (LAS float*)F.lds;
    for (int i = F.tid; i < 11 * (D / 4); i += NTHREADS) { const int t = i / (D / 4), c = 4 * (i % (D / 4)); f32x4 v;
        if (t == 0) v = *(const GAS f32x4*)(a.in[I_LNFG] + layer * D + c);
        else if (t == 1) v = *(const GAS f32x4*)(a.in[I_LNFB] + layer * D + c);
        else { const int r = (t - 2) / 3, k = (t - 2) % 3;
            if (k == 0) v = *(const GAS f32x4*)(modp(F.ws, layer, r, 5) + c);
            else if (layer == 0) { v = *(const GAS f32x4*)(modp(F.ws, 1, r, k == 1 ? 1 : 0) + c); if (k == 1) v = v + 1.0f; }
            else v = (f32x4){0.f, 0.f, 0.f, 0.f}; }
        *(LAS f32x4*)(P + t * D + c) = v; }
    __syncthreads();
    for (int vb = F.bid; vb < 256; vb += F.G) {
        for (int j = F.wave; j < TPB; j += 8) { const int row = tok0 + vb * TPB + j;
            f32x4 f[8];
            { const unsigned char* ys = YS + (size_t)(start64 + row - tok0) * D;
#pragma unroll
              for (int i = 0; i < 8; ++i) f[i] = up4_fp8(*(const GAS unsigned*)(ys + 4 * F.lane + 256 * i)) * 0.0625f; }
#pragma unroll 2
            for (int jj = 0; jj < 8; ++jj) { const int slot = TOK_SLOT[row * 8 + jj]; const float w = SW[row * 8 + jj] * 0.0625f; const unsigned char* ys = YS + (size_t)slot * D;
#pragma unroll
                for (int i = 0; i < 8; ++i) f[i] += up4_fp8(*(const GAS unsigned*)(ys + 4 * F.lane + 256 * i)) * w; }
            const int r = modrow(row); bf16_t* xr = X + (size_t)row * D; float s = 0.f;
            const LAS float* pg2 = P + (2 + 3 * r) * D;
#pragma unroll
            for (int i = 0; i < 8; ++i) { const int c = 4 * F.lane + 256 * i; const u32x2 p = *(const GAS u32x2*)(xr + c); const f32x4 xv = {bflo(p.x), bfhi(p.x), bflo(p.y), bfhi(p.y)};
                f[i] = xv * ALPHA + *(const LAS f32x4*)(pg2 + c) * f[i]; s += (f[i][0] + f[i][1]) + (f[i][2] + f[i][3]); }
            const float mean = wave_sum(s) * (1.0f / D); float ss = 0.f;
#pragma unroll
            for (int i = 0; i < 8; ++i) { f[i] = f[i] - mean; ss += (f[i][0] * f[i][0] + f[i][1] * f[i][1]) + (f[i][2] * f[i][2] + f[i][3] * f[i][3]); }
            const float rstd = rsqrtf(wave_sum(ss) * (1.0f / D) + LN_EPS);
            if (layer == 0) { const LAS float* psc = P + (3 + 3 * r) * D; const LAS float* psh = P + (4 + 3 * r) * D;
#pragma unroll
                for (int i = 0; i < 8; ++i) { const int c = 4 * F.lane + 256 * i;
                    const f32x4 lat = f[i] * rstd * *(const LAS f32x4*)(P + c) + *(const LAS f32x4*)(P + D + c);
                    { u32x2 wl; wl.x = pk2(lat[0], lat[1]); wl.y = pk2(lat[2], lat[3]); *(GAS u32x2*)(xr + c) = wl; }
                    const f32x4 h = lat * *(const LAS f32x4*)(psc + c) + *(const LAS f32x4*)(psh + c);
                    u32x2 w; w.x = pk2(h[0], h[1]); w.y = pk2(h[2], h[3]); *(GAS u32x2*)(A0 + (size_t)row * D + c) = w; } }
            else { float* o = a.out + (size_t)(row - TC) * D;
#pragma unroll
                for (int i = 0; i < 8; ++i) { const int c = 4 * F.lane + 256 * i; *(GAS f32x4*)(o + c) = f[i] * rstd * *(const LAS f32x4*)(P + c) + *(const LAS f32x4*)(P + D + c); } }
        }
    }
}

__device__ __forceinline__ void phase_attention(const Frame& F, const Args& a) {
    constexpr int ABUF = 35840;
    const bf16_t* QK = (const bf16_t*)(F.ws + WS_Z); const bf16_t* VT = (const bf16_t*)(F.ws + WS_YTL); bf16_t* O = (bf16_t*)(F.ws + WS_MIX);
    const int fr = F.lane & 15, fq = F.lane >> 4;
    const int key0 = F.tid >> 4, c16 = F.tid & 15, dim0 = F.tid >> 3, c8 = F.tid & 7;
    for (int unit = ((F.G % 8 == 0) ? (F.bid % 8) * (F.G / 8) + F.bid / 8 : F.bid); unit < 256; unit += F.G) {
        const int b = unit >> 7, h = (unit >> 5) & 3, n = unit & 31;
        const int kt_lo = (2 * n - 2) < 0 ? 0 : (2 * n - 2), kt_hi = (2 * n + 3) > 63 ? 63 : (2 * n + 3), nband = kt_hi - kt_lo + 1, ntile = nband + 4, nstep = 2 * ntile;
        u32x4 kreg[2], vreg[2];
        const bf16_t* kbase = QK + 2048 + h * 128 + 8 * c16; const bf16_t* vbase = VT + (size_t)(h * 128 + dim0) * T0 + 8 * c8;
#define ATT_LOAD(step_) do { const int ti_ = (step_) % ntile; const bool cx_ = ti_ >= nband; const int kt_ = cx_ ? (ti_ - nband) : (kt_lo + ti_); const int kr_ = cx_ ? (b * CTXL + 64 * kt_) : (TC + b * SEQ + 64 * kt_); \
            kreg[0] = *(const GAS u32x4*)(kbase + (size_t)(kr_ + key0) * 2560); kreg[1] = *(const GAS u32x4*)(kbase + (size_t)(kr_ + key0 + 32) * 2560); \
            vreg[0] = *(const GAS u32x4*)(vbase + kr_); vreg[1] = *(const GAS u32x4*)(vbase + (size_t)64 * T0 + kr_); } while (0)
#define ATT_STORE(buf_) do { LAS bf16_t* Ks_ = (LAS bf16_t*)(F.lds + (buf_) * ABUF); LAS bf16_t* Vs_ = (LAS bf16_t*)(F.lds + (buf_) * ABUF + 17408); \
            *(LAS u32x4*)(Ks_ + key0 * 136 + 8 * c16) = kreg[0]; *(LAS u32x4*)(Ks_ + (key0 + 32) * 136 + 8 * c16) = kreg[1]; \
            *(LAS u32x4*)(Vs_ + dim0 * 72 + 8 * c8) = vreg[0]; *(LAS u32x4*)(Vs_ + (dim0 + 64) * 72 + 8 * c8) = vreg[1]; } while (0)
        __syncthreads();
        ATT_LOAD(0); ATT_STORE(0);
        __syncthreads();
        bf16x8 aq[2][4]; float mrun[2], lrun[2]; f32x4 o[2][8]; int qh = 0, qpos0 = 0, qrow = 0;
        for (int step = 0; step < nstep; ++step) {
            const int ti = step % ntile, pass = step / ntile;
            if (step + 1 < nstep) ATT_LOAD(step + 1);
            if (ti == 0) {
                qh = h * 4 + 2 * pass + (F.wave >> 2); const int rows0 = (F.wave & 3) * 32; qpos0 = n * 128 + rows0; qrow = TC + b * SEQ + qpos0;
#pragma unroll
                for (int m = 0; m < 2; ++m)
#pragma unroll
                    for (int kk = 0; kk < 4; ++kk) aq[m][kk] = *(const GAS bf16x8*)(QK + (size_t)(qrow + 16 * m + fr) * 2560 + qh * 128 + 32 * kk + 8 * fq);
                const float sink = a.in[I_SINK][qh];
                mrun[0] = sink; mrun[1] = sink; lrun[0] = 1.f; lrun[1] = 1.f;
#pragma unroll
                for (int m = 0; m < 2; ++m)
#pragma unroll
                    for (int nd = 0; nd < 8; ++nd) o[m][nd] = (f32x4){0.f, 0.f, 0.f, 0.f};
            }
            const bool isctx = ti >= nband; const int kt = isctx ? (ti - nband) : (kt_lo + ti);
            const LAS bf16_t* Ks = (const LAS bf16_t*)(F.lds + (step & 1) * ABUF); const LAS bf16_t* Vs = (const LAS bf16_t*)(F.lds + (step & 1) * ABUF + 17408);
            f32x4 s[2][4];
#pragma unroll
            for (int m = 0; m < 2; ++m)
#pragma unroll
                for (int nn = 0; nn < 4; ++nn) s[m][nn] = (f32x4){0.f, 0.f, 0.f, 0.f};
#pragma unroll
            for (int kk = 0; kk < 4; ++kk)
#pragma unroll
                for (int nn = 0; nn < 4; ++nn) { const bf16x8 kf = *(const LAS bf16x8*)(Ks + (16 * nn + fr) * 136 + 32 * kk + 8 * fq);
#pragma unroll
                    for (int m = 0; m < 2; ++m) s[m][nn] = __builtin_amdgcn_mfma_f32_16x16x32_bf16(kf, aq[m][kk], s[m][nn], 0, 0, 0); }
            bf16x8 pf[2][2];
#pragma unroll
            for (int m = 0; m < 2; ++m) {
                if (!isctx) { const int qpos = qpos0 + 16 * m + fr;
#pragma unroll
                    for (int nn = 0; nn < 4; ++nn)
#pragma unroll
                        for (int j = 0; j < 4; ++j) { const int d = 64 * kt + 16 * nn + 4 * fq + j - qpos; if (d > 128 || d < -128) s[m][nn][j] = -INFINITY; } }
                float mx = s[m][0][0];
#pragma unroll
                for (int nn = 0; nn < 4; ++nn)
#pragma unroll
                    for (int j = 0; j < 4; ++j) mx = fmaxf(mx, s[m][nn][j]);
                mx = fmaxf(mx, __shfl_xor(mx, 16)); mx = fmaxf(mx, __shfl_xor(mx, 32));
                const float mnew = fmaxf(mrun[m], mx), alpha = __expf(mrun[m] - mnew); mrun[m] = mnew;
                float rs = 0.f;
#pragma unroll
                for (int nn = 0; nn < 4; ++nn)
#pragma unroll
                    for (int j = 0; j < 4; ++j) { const float p = __expf(s[m][nn][j] - mnew); s[m][nn][j] = p; rs += p; }
                rs += __shfl_xor(rs, 16); rs += __shfl_xor(rs, 32);
                lrun[m] = lrun[m] * alpha + rs;
#pragma unroll
                for (int nd = 0; nd < 8; ++nd) o[m][nd] = o[m][nd] * alpha;
#pragma unroll
                for (int ks = 0; ks < 2; ++ks) { u32x4 w; w.x = cvt_pk_bf16(s[m][2 * ks][0], s[m][2 * ks][1]); w.y = cvt_pk_bf16(s[m][2 * ks][2], s[m][2 * ks][3]);
                    w.z = cvt_pk_bf16(s[m][2 * ks + 1][0], s[m][2 * ks + 1][1]); w.w = cvt_pk_bf16(s[m][2 * ks + 1][2], s[m][2 * ks + 1][3]); pf[m][ks] = __builtin_bit_cast(bf16x8, w); }
            }
#pragma unroll
            for (int ks = 0; ks < 2; ++ks)
#pragma unroll
                for (int nd = 0; nd < 8; ++nd) { const LAS bf16_t* vp = Vs + (16 * nd + fr) * 72 + 32 * ks + 4 * fq;
                    u32x4 w; const u32x2 lo = *(const LAS u32x2*)vp, hi = *(const LAS u32x2*)(vp + 16); w.x = lo.x; w.y = lo.y; w.z = hi.x; w.w = hi.y;
                    const bf16x8 vf = __builtin_bit_cast(bf16x8, w);
#pragma unroll
                    for (int m = 0; m < 2; ++m) o[m][nd] = __builtin_amdgcn_mfma_f32_16x16x32_bf16(vf, pf[m][ks], o[m][nd], 0, 0, 0); }
            if (ti == ntile - 1) {
#pragma unroll
                for (int m = 0; m < 2; ++m) { const float inv = 1.0f / lrun[m]; bf16_t* op = O + (size_t)(qrow + 16 * m + fr) * D + qh * 128 + 4 * fq;
#pragma unroll
                    for (int nd = 0; nd < 8; ++nd) { const f32x4 v = o[m][nd] * inv; u32x2 w; w.x = cvt_pk_bf16(v[0], v[1]); w.y = cvt_pk_bf16(v[2], v[3]); *(GAS u32x2*)(op + 16 * nd) = w; } }
            }
            if (step + 1 < nstep) ATT_STORE((step + 1) & 1);
            __syncthreads();
        }
#undef ATT_LOAD
#undef ATT_STORE
    }
}

constexpr int NPHASE = 20;
__global__ void __launch_bounds__(NTHREADS, 2) mk_fwd(Args args) {
    extern __shared__ __attribute__((aligned(16))) unsigned char lds_raw[];
    Frame F; F.lds = (LAS unsigned char*)lds_raw; F.tid = threadIdx.x; F.lane = F.tid & 63; F.wave = __builtin_amdgcn_readfirstlane(F.tid >> 6); F.G = gridDim.x; F.bid = blockIdx.x; F.ws = args.ws;
    volatile LAS unsigned* MISC = (volatile LAS unsigned*)(F.lds + MISC_OFF + 1024);
    if (F.tid < 16) MISC[F.tid] = 0u;
    __syncthreads();
    unsigned* ctl = (unsigned*)(args.ws + WS_CTL);
    XcdBarrier bar; bar.bar = ctl + CW_BAR; bar.x = 0; bar.st = nullptr;
    if (!MK_PER_PHASE) bar = xcd_barrier_post(ctl + CW_BAR, MISC + 8);
    const int lo = args.ph_lo, hi = args.ph_hi;
    unsigned char* ws = args.ws;
#ifndef DUP_PHASE
#define DUP_PHASE -1
#endif
#define IN(k) (lo <= (k) && (k) < hi)
#define REP(k) for (int rep_ = 0; rep_ < ((k) == DUP_PHASE ? 2 : 1); ++rep_)
#define SEAM(k) do { if (IN(k) && IN((k) + 1)) xcd_barrier(bar); } while (0)
    LAS unsigned char* ring = F.lds;
    LAS i32x4* ut = (LAS i32x4*)(F.lds + MISC_OFF + 1152);
    constexpr int QD = 8, QD2 = 11, QG = 3, QM = 1, QS = 4;
    const int vcu = (F.G % 8 == 0) ? (F.bid % 8) * (F.G / 8) + F.bid / 8 : F.bid;

    if (IN(0)) REP(0) { conv_range(F, args, 0, cv::N3 + cv::HALFM); conv_range(F, args, cv::NG, cv::NG + cv::HALFM);
        __syncthreads(); p0_mod(F, args); p0_tables(F, args.in[I_RW]); }
    SEAM(0);
    if (IN(1)) REP(1) phase_modulate0(F, args);
    SEAM(1);
    if (IN(2)) REP(2) { DenseSched S{(const char*)(ws + WS_A0), (const char*)(ws + WS_WIN), D, D, 34, 12, F.G, F.bid}; EpiWin E{(bf16_t*)(ws + WS_Z)};
        pg8::gemm_phase<EpiWin, DenseSched>(ring, D, D, S, E); if (F.bid >= 408 - F.G) conv_pull(F, args, QD2); }
    SEAM(2);
    if (IN(3)) REP(3) { Dft1Sched S{ws, F.G, F.bid}; EpiBf16G E{(bf16_t*)(ws + WS_YTL), (bf16_t*)(ws + WS_YTC), SEQ, CTXL, 1.0f, 1.0f};
        pg8::gemm_phase<EpiBf16G, Dft1Sched>(ring, 256, 3072, S, E); __syncthreads(); phase_sgu(F, args); if (F.bid >= 2 * (272 - F.G)) conv_pull(F, args, QS); }
    SEAM(3);
    if (IN(4)) REP(4) phase_butterfly(F);
    SEAM(4);
    if (IN(5)) REP(5) { Dft2Sched S{ws, F.G, F.bid}; EpiBf16G E{(bf16_t*)(ws + WS_MIX), (bf16_t*)(ws + WS_MIX), D, D, 1.0f / 1024.0f, 1.0f / 256.0f};
        pg8::gemm_phase<EpiBf16G, Dft2Sched>(ring, 512, 512, S, E); if (F.bid >= 136) conv_pull(F, args, QS); }
    SEAM(5);
    if (IN(6)) REP(6) { const int g6 = (F.G == 256) ? 136 : F.G;
        DenseSched S{(const char*)(ws + WS_MIX), (const char*)(ws + WS_WOUT), D, D, 34, 8, g6, F.bid}; EpiResid E{(bf16_t*)(ws + WS_X), args.in[I_X], args.in[I_CTX], ws, 0, 0};
        pg8::gemm_phase<EpiResid, DenseSched>(ring, D, D, S, E);
        if (F.bid >= g6) conv_pull(F, args, 26); else if (F.G != 256 && F.bid >= 272 - F.G) conv_pull(F, args, QD); }
    SEAM(6);
    if (IN(7)) REP(7) phase_ln_router(F, args, 0);
    SEAM(7);
    if (IN(8)) REP(8) { phase_scatter(F, 0); conv_cleanup(F, args, cv::HALFM); }
    SEAM(8);
    if (IN(9)) REP(9) { moe_tables(F, 4, F.G, true); MoeSched S{ws, ut, (const int*)(ws + WS_SLOTTOK), 0}; EpiGateUp E{(bf16_t*)(ws + WS_ACT)};
        pg8::gemm_phase<EpiGateUp, MoeSched, true, true, 122>(ring, D / 2, D / 2, S, E); if (moe_conv(F)) conv_pull(F, args, 34); else if (moe_short(F)) conv_pull(F, args, QG); }
    SEAM(9);
    if (IN(10)) REP(10) { moe_tables(F, 8, F.G, true); MoeDownSched S{ws, ut, 0}; EpiYs8 E{ws + WS_YS};
        pg8::gemm_phase<EpiYs8, MoeDownSched, true, true, 122>(ring, EDIM / 2, EDIM / 2, S, E); if (moe_conv(F)) conv_pull(F, args, 24); else if (moe_short(F)) conv_pull(F, args, QM); }
    SEAM(10);
    if (IN(11)) REP(11) phase_combine(F, args, 0);
    SEAM(11);
    if (IN(12)) REP(12) { QkvSched S{ws, F.G, F.bid}; EpiQkv E{(bf16_t*)(ws + WS_Z), (bf16_t*)(ws + WS_YTL), (const f32x2*)(ws + WS_ROPE)};
        pg8::gemm_phase<EpiQkv, QkvSched>(ring, D, D, S, E); if (F.bid >= 392 - F.G) conv_pull(F, args, QD2); }
    SEAM(12);
    if (IN(13)) REP(13) phase_attention(F, args);
    SEAM(13);
    if (IN(14)) REP(14) { DenseSched S{(const char*)(ws + WS_MIX) + (size_t)TC * D * 2, (const char*)(ws + WS_WAO), D, D, 32, 8, F.G, F.bid}; EpiResid E{(bf16_t*)(ws + WS_X), nullptr, nullptr, ws, 1, TC};
        pg8::gemm_phase<EpiResid, DenseSched>(ring, D, D, S, E); }
    SEAM(14);
    if (IN(15)) REP(15) phase_ln_router(F, args, 1);
    SEAM(15);
    if (IN(16)) REP(16) { phase_scatter(F, 1); conv_cleanup(F, args, 4 * cv::HALFM); }
    SEAM(16);
    if (IN(17)) REP(17) { moe_tables(F, 4, F.G, false); MoeSched S{ws, ut, (const int*)(ws + WS_SLOTTOK), 1}; EpiGateUp E{(bf16_t*)(ws + WS_ACT)};
        pg8::gemm_phase<EpiGateUp, MoeSched, true, true, 122>(ring, D / 2, D / 2, S, E); }
    SEAM(17);
    if (IN(18)) REP(18) { moe_tables(F, 8, F.G, false); MoeDownSched S{ws, ut, 1}; EpiYs8 E{ws + WS_YS};
        pg8::gemm_phase<EpiYs8, MoeDownSched, true, true, 122>(ring, EDIM / 2, EDIM / 2, S, E); }
    SEAM(18);
    if (IN(19)) REP(19) phase_combine(F, args, 1);
#undef IN
#undef SEAM
}

extern "C" void kernel_launch(void* const* d_in, const int* in_sizes, int n_in, void* d_out, int out_size, void* d_ws, size_t ws_size, hipStream_t stream) {
    static int grid = 0;
    if (grid == 0) {
        if (n_in != 27 || out_size != TL * D || ws_size < WS_END) { fprintf(stderr, "kernel_launch: unexpected shapes (n_in %d out %d ws %zu)\n", n_in, out_size, ws_size); grid = -1; return; }
        int dev = 0, cus = 0, per_cu = 0;
        if (hipGetDevice(&dev) != hipSuccess || hipDeviceGetAttribute(&cus, hipDeviceAttributeMultiprocessorCount, dev) != hipSuccess) { grid = -1; return; }
        if (hipFuncSetAttribute((const void*)mk_fwd, hipFuncAttributeMaxDynamicSharedMemorySize, LDS_BYTES) != hipSuccess) { fprintf(stderr, "kernel_launch: hipFuncSetAttribute failed\n"); grid = -1; return; }
        if (hipOccupancyMaxActiveBlocksPerMultiprocessor(&per_cu, (const void*)mk_fwd, NTHREADS, LDS_BYTES) != hipSuccess || per_cu < 1) fprintf(stderr, "kernel_launch: occupancy query reports %d\n", per_cu);
        (void)hipGetLastError();
        grid = cus < 256 ? cus : 256;
    }
    if (grid < 0) return;
    (void)hipMemsetAsync((char*)d_ws + WS_CTL, 0, CTL_ZERO_BYTES, stream);
    Args a{};
    for (int i = 0; i < 27; ++i) a.in[i] = (const float*)d_in[i];
    a.out = (float*)d_out; a.ws = (unsigned char*)d_ws;
#if MK_PER_PHASE
    for (int p = 0; p < NPHASE; ++p) { a.ph_lo = p; a.ph_hi = p + 1; hipLaunchKernelGGL(mk_fwd, dim3(grid), dim3(NTHREADS), LDS_BYTES, stream, a); }
#else
    a.ph_lo = 0; a.ph_hi = NPHASE; hipLaunchKernelGGL(mk_fwd, dim3(grid), dim3(NTHREADS), LDS_BYTES, stream, a);
#endif
}
```

```cpp
#include <hip/hip_runtime.h>
#include <cstdio>
#include <cstdint>

#ifndef MK_PER_PHASE
#define MK_PER_PHASE 0
#endif

#define GAS __attribute__((address_space(1)))
#define LAS __attribute__((address_space(3)))
typedef unsigned short bf16_t;
typedef short bf16x8 __attribute__((ext_vector_type(8)));
typedef float f32x4 __attribute__((ext_vector_type(4)));
typedef float f32x2 __attribute__((ext_vector_type(2)));
typedef unsigned u32x4 __attribute__((ext_vector_type(4)));
typedef unsigned u32x2 __attribute__((ext_vector_type(2)));

constexpr int D = 2048, SEQ = 4096, CTXL = 256, NBATCH = 2;
constexpr int TC = NBATCH * CTXL;
constexpr int TL = NBATCH * SEQ;
constexpr int T0 = TC + TL;
constexpr int NEXP = 64, EDIM = 512, TOPK = 8;
constexpr int NE1 = NEXP + 1;
constexpr int SLOTS = 98304;
constexpr float ALPHA = 1.4142135623730951f;
constexpr float LN_EPS = 1e-6f;
constexpr float QSCALE = 0.08838834764831845f;

constexpr size_t MiB = 1u << 20;
constexpr size_t WS_CTL = 0, CTL_ZERO_BYTES = 32 * 1024;
constexpr size_t WS_MOD = 1 * MiB;
constexpr size_t WS_ROPE = 1 * MiB + 512 * 1024;
constexpr size_t WS_WCT = 2 * MiB;
constexpr size_t WS_T256 = 2 * MiB + 256 * 1024;
constexpr size_t WS_RWH = 2 * MiB + 512 * 1024;
constexpr size_t WS_SELE = 3 * MiB;
constexpr size_t WS_SELW = 3 * MiB + 512 * 1024;
constexpr size_t WS_HIST = 4 * MiB;
constexpr size_t WS_EXPT = 4 * MiB + 128 * 1024;
constexpr size_t WS_SLOTTOK = 4 * MiB + 256 * 1024;
constexpr size_t WS_TOKSLOT = 5 * MiB;
constexpr size_t WS_RWL = 6 * MiB;
constexpr size_t WS_WIN = 8 * MiB;
constexpr size_t WS_WOUT = 20 * MiB;
constexpr size_t WS_WQK = 28 * MiB;
constexpr size_t WS_WV = 38 * MiB;
constexpr size_t WS_WAO = 40 * MiB;
constexpr size_t WS_WGU = 48 * MiB;
constexpr size_t WGU_E = (size_t)1024 * 2048 * 2, WGU_L = 65 * WGU_E;
constexpr size_t WS_WD = WS_WGU + 2 * WGU_L;
constexpr size_t WD_E = (size_t)2048 * 512 * 2, WD_L = 65 * WD_E;
constexpr size_t WGU8_E = (size_t)1024 * 2048, WGU8_L = 65 * WGU8_E;
constexpr size_t WD8_E = (size_t)2048 * 512, WD8_L = 65 * WD8_E;
constexpr size_t WS_X = 832 * MiB;
constexpr size_t WS_A0 = 900 * MiB;
constexpr size_t WS_Z = 934 * MiB;
constexpr size_t WS_YTL = 985 * MiB;
constexpr size_t WS_YTC = 1017 * MiB;
constexpr size_t WS_GT = 1019 * MiB;
constexpr size_t WS_MIX = 1051 * MiB;
constexpr size_t WS_ACT = 1085 * MiB;
constexpr size_t WS_YS = 1181 * MiB;
constexpr size_t WS_END = 1565 * MiB;
static_assert(WS_WD + 2 * WD_L <= WS_X && WS_YS + (size_t)SLOTS * 2048 * 2 <= WS_END, "ws map");
constexpr int CW_BAR = 4096;
static_assert((CW_BAR + 3456) * 4 <= (int)CTL_ZERO_BYTES, "barrier words inside the per-call memset");

constexpr int RING_BYTES = 131072;
constexpr int MISC_OFF = 145408;
constexpr int LDS_BYTES = 147456;
constexpr int NWAVES = 8, NTHREADS = 512;

#define LDS_WAIT() asm volatile("s_waitcnt lgkmcnt(0)" ::: "memory")
#define VM_WAIT() asm volatile("s_waitcnt vmcnt(0)" ::: "memory")
__device__ __forceinline__ unsigned f2bf(float f) { unsigned u = __builtin_bit_cast(unsigned, f); return (u + 0x7fffu + ((u >> 16) & 1u)) >> 16; }
__device__ __forceinline__ unsigned pk2(float lo, float hi) { return f2bf(lo) | (f2bf(hi) << 16); }
__device__ __forceinline__ float bf2f(unsigned short b) { return __builtin_bit_cast(float, ((unsigned)b) << 16); }
__device__ __forceinline__ float bflo(unsigned w) { return __builtin_bit_cast(float, w << 16); }
__device__ __forceinline__ float bfhi(unsigned w) { return __builtin_bit_cast(float, w & 0xffff0000u); }
__device__ __forceinline__ float wave_sum(float v) {
#pragma unroll
    for (int o = 1; o < 64; o <<= 1) v += __shfl_xor(v, o);
    return v;
}
__device__ __forceinline__ float gelu_tanh(float x) { const float u = 0.7978845608028654f * (x + 0.044715f * x * x * x); return x * __builtin_amdgcn_rcpf(1.0f + __expf(-2.0f * u)); }
__device__ __forceinline__ float sat8(float x) { return __builtin_amdgcn_fmed3f(x, -448.0f, 448.0f); }
__device__ __forceinline__ unsigned pk4_fp8(float a, float b, float c, float d) { int w = 0; w = __builtin_amdgcn_cvt_pk_fp8_f32(sat8(a), sat8(b), w, false); w = __builtin_amdgcn_cvt_pk_fp8_f32(sat8(c), sat8(d), w, true); return (unsigned)w; }
__device__ __forceinline__ f32x4 up4_fp8(unsigned w) { const f32x2 lo = __builtin_amdgcn_cvt_pk_f32_fp8((int)w, false), hi = __builtin_amdgcn_cvt_pk_f32_fp8((int)w, true); return (f32x4){lo[0], lo[1], hi[0], hi[1]}; }
__device__ __forceinline__ float silu_f(float x) { return x * __builtin_amdgcn_rcpf(1.0f + __expf(-x)); }

#define XB_TMO      128
#define XB_XCNT(j)  (256  + 64 * (j))
#define XB_XSUB(j)  (1280 + 64 * (j))
#define XB_XGEN(j)  (2304 + 64 * (j))
#define XB_TOP      3328
#define XB_TOPGEN   3392
#define XCD_BAR_WORDS 3456
#define XB_SPIN_CAP (1u << 18)
__device__ __forceinline__ unsigned xb_ld(unsigned* p)              { return __hip_atomic_load(p, __ATOMIC_RELAXED, __HIP_MEMORY_SCOPE_AGENT); }
__device__ __forceinline__ unsigned xb_add(unsigned* p, unsigned v) { return __hip_atomic_fetch_add(p, v, __ATOMIC_RELAXED, __HIP_MEMORY_SCOPE_AGENT); }
__device__ __forceinline__ unsigned xb_xcc_id() { return (unsigned)__builtin_amdgcn_s_getreg((3 << 11) | 20) & 0xFu; }
#define XB_SPIN(cond, bar) do { unsigned _sp = 0; while (cond) { __builtin_amdgcn_s_sleep(1); \
    if ((++_sp & 255u) == 0u) { if (xb_ld(&(bar)[XB_TMO])) break; if (_sp > XB_SPIN_CAP) { atomicAdd(&(bar)[XB_TMO], 1u); break; } } } } while (0)
struct XcdBarrier { unsigned* bar; unsigned x; volatile LAS unsigned* st; };
__device__ __forceinline__ XcdBarrier xcd_barrier_post(unsigned* bar, volatile LAS unsigned* st) {
    XcdBarrier b; b.bar = bar; b.x = xb_xcc_id(); b.st = st;
    if (threadIdx.x == 0) (void)xb_add(&bar[XB_XCNT(b.x)], 1u);
    return b;
}
__device__ __forceinline__ void xcd_barrier_complete(unsigned* bar, unsigned x, unsigned& nloc, unsigned& nx) {
    const unsigned G = gridDim.x * gridDim.y * gridDim.z;
    unsigned sum, cnt, mine, sp = 0u;
    for (;;) {
        sum = 0u; cnt = 0u; mine = 0u;
#pragma unroll
        for (unsigned j = 0; j < 16; ++j) { const unsigned c = xb_ld(&bar[XB_XCNT(j)]); sum += c; cnt += (c > 0u) ? 1u : 0u; mine = (j == x) ? c : mine; }
        if (sum == G) break;
        __builtin_amdgcn_s_sleep(1);
        if ((++sp & 255u) == 0u) { if (xb_ld(&bar[XB_TMO])) break; if (sp > XB_SPIN_CAP) { atomicAdd(&bar[XB_TMO], 1u); break; } }
    }
    nloc = mine > 0u ? mine : 1u; nx = cnt > 0u ? cnt : 1u;
}
__device__ __forceinline__ void xcd_barrier(const XcdBarrier& b) {
    asm volatile("s_waitcnt vmcnt(0)" ::: "memory");
    __syncthreads();
    if (threadIdx.x == 0) {
        unsigned* bar = b.bar;
        __builtin_amdgcn_s_waitcnt(0);
        unsigned nloc = b.st[0], nx = b.st[1];
        if (nloc == 0u) { xcd_barrier_complete(bar, b.x, nloc, nx); b.st[0] = nloc; b.st[1] = nx; }
        const unsigned old = xb_add(&bar[XB_XSUB(b.x)], 1u);
        const unsigned gen = old / nloc;
        if (old + 1u == (gen + 1u) * nloc) {
            __builtin_amdgcn_fence(__ATOMIC_RELEASE, "agent");
            asm volatile("s_waitcnt vmcnt(0)" ::: "memory");
            const unsigned og = xb_add(&bar[XB_TOP], 1u);
            const unsigned tg = og / nx;
            if (og + 1u == (tg + 1u) * nx) xb_add(&bar[XB_TOPGEN], 1u);
            else XB_SPIN(xb_ld(&bar[XB_TOPGEN]) == tg, bar);
            __builtin_amdgcn_fence(__ATOMIC_ACQUIRE, "agent");
            xb_add(&bar[XB_XGEN(b.x)], 1u);
            asm volatile("s_waitcnt vmcnt(0)" ::: "memory");
        } else {
            XB_SPIN(xb_ld(&bar[XB_XGEN(b.x)]) == gen, bar);
            __builtin_amdgcn_fence(__ATOMIC_ACQUIRE, "agent");
            asm volatile("s_waitcnt vmcnt(0)" ::: "memory");
        }
    }
    __syncthreads();
}

namespace pg8 {
constexpr int BM = 256, BK = 64, HALF = 128, HTB = HALF * BK * 2, NXCD = 8, WGM = 8;
__host__ __device__ __forceinline__ int lds_byte(int r, int c) { const int st = (r >> 4) * 2 + (c >> 5), rr = r & 15, cc = c & 31, ob = rr * 64 + cc * 2; return st * 1024 + (ob ^ (((ob >> 9) & 1) << 5)); }
__host__ __device__ __forceinline__ void stage_rc(int b, int& R, int& C) { const int st = b / 1024, sb = b % 1024, swz = sb ^ (((sb >> 9) & 1) << 5); R = (st >> 1) * 16 + swz / 64; C = (st & 1) * 32 + (swz % 64) / 2; }
__host__ __device__ __forceinline__ int perm32(int rho) { const int n = rho >> 4, i = rho & 15; return 8 * (i >> 2) + 4 * n + (i & 3); }
__device__ __forceinline__ unsigned cvt_pk_bf16(float lo, float hi) { unsigned r; asm volatile("v_cvt_pk_bf16_f32 %0, %1, %2" : "=v"(r) : "v"(lo), "v"(hi)); return r; }

struct Unit { const char* a; const char* b; int i0, i1, i2, i3; };

__device__ __forceinline__ void tile_order(int L, int nM, int nN, int& pm, int& pn) {
    const int nwg = nM * nN; int wgid = L;
    { const int q = nwg / NXCD, r = nwg % NXCD, xcd = wgid % NXCD, off = wgid / NXCD; wgid = (xcd < r ? xcd * (q + 1) : r * (q + 1) + (xcd - r) * q) + off; }
    const int nig = WGM * nN, gid = wgid / nig, fm = gid * WGM, gsz = (nM - fm) < WGM ? (nM - fm) : WGM;
    pm = fm + ((wgid % nig) % gsz); pn = (wgid % nig) / gsz;
}

typedef int i32x4m __attribute__((ext_vector_type(4)));
typedef int i32x8m __attribute__((ext_vector_type(8)));
__device__ __forceinline__ i32x8m cat8(bf16x8 a, bf16x8 b) { return __builtin_shufflevector(__builtin_bit_cast(i32x4m, a), __builtin_bit_cast(i32x4m, b), 0, 1, 2, 3, 4, 5, 6, 7); }
template <class Epi, class Sched, bool ALIGN_EPI = true, bool F8 = false, int SCALE_B = 127>
__device__ __forceinline__ void gemm_phase(LAS unsigned char* lds, const int K, const int ldb, const Sched& S, const Epi& E) {
    const int tid = threadIdx.x, wid = __builtin_amdgcn_readfirstlane(tid >> 6), lane = tid & 63, wr = wid >> 2, wc = wid & 3, fr = lane & 15, fq = lane >> 4;
    const int nt = K / BK;
    int sR[2], sC[2]; unsigned voffB[2];
#pragma unroll
    for (int i = 0; i < 2; ++i) { stage_rc(tid * 16 + i * 8192, sR[i], sC[i]); int Rb = Epi::PERM ? ((sR[i] & ~31) + perm32(sR[i] & 31)) : sR[i];
        if constexpr ((int)Epi::PERM == 2) Rb = 64 * (sR[i] >> 5) + 16 * ((sR[i] >> 2) & 3) + 4 * ((sR[i] >> 4) & 1) + (sR[i] & 3);
        voffB[i] = (unsigned)(Rb * ldb + sC[i]) * 2u; }
    const size_t kstep = (size_t)(BK * 2);
    const size_t hstepB = (size_t)((int)Epi::PERM == 2 ? 8 : HALF) * ldb * 2;
    const unsigned ldsw = (unsigned)wid * 1024u;
    const int aoff = lds_byte(wr * 64 + fr, fq * 8), boff = lds_byte(wc * 32 + fr, fq * 8);
#define PG8_SA(b, h) (((b) * 2 + (h)) * HTB)
#define PG8_SB(b, h) ((4 + (b) * 2 + (h)) * HTB)
#define PG8_STAGE2(bufoff, gbase, v0, v1) do { \
        __builtin_amdgcn_global_load_lds((const unsigned*)((const char*)(gbase) + (v0)), (LAS unsigned*)(lds + (bufoff) + ldsw), 16, 0, 0); \
        __builtin_amdgcn_global_load_lds((const unsigned*)((const char*)(gbase) + (v1)), (LAS unsigned*)(lds + (bufoff) + ldsw + 8192), 16, 0, 0); } while (0)
#define PG8_STAGEB(bufoff, gbase) PG8_STAGE2(bufoff, gbase, voffB[0], voffB[1])
#define PG8_LDA(dst, b, h) do { _Pragma("unroll") for (int m = 0; m < 4; ++m) { if constexpr (F8) dst##8[m] = cat8(*(const LAS bf16x8*)(lds + PG8_SA(b, h) + aoff + m * 2048), *(const LAS bf16x8*)(lds + PG8_SA(b, h) + aoff + m * 2048 + 1024)); \
        else { _Pragma("unroll") for (int k = 0; k < 2; ++k) dst[m][k] = *(const LAS bf16x8*)(lds + PG8_SA(b, h) + aoff + m * 2048 + k * 1024); } } } while (0)
#define PG8_LDB(dst, b, h) do { _Pragma("unroll") for (int n = 0; n < 2; ++n) { if constexpr (F8) dst##8[n] = cat8(*(const LAS bf16x8*)(lds + PG8_SB(b, h) + boff + n * 2048), *(const LAS bf16x8*)(lds + PG8_SB(b, h) + boff + n * 2048 + 1024)); \
        else { _Pragma("unroll") for (int k = 0; k < 2; ++k) dst[n][k] = *(const LAS bf16x8*)(lds + PG8_SB(b, h) + boff + n * 2048 + k * 1024); } } } while (0)
#define PG8_MMA(ai, bj, At, Bt) do { __builtin_amdgcn_s_setprio(1); _Pragma("unroll") for (int m = 0; m < 4; ++m) _Pragma("unroll") for (int n = 0; n < 2; ++n) { \
        if constexpr (F8) asm volatile("v_mfma_scale_f32_16x16x128_f8f6f4 %0, %1, %2, %0, %3, %4 op_sel_hi:[0,0,0]" : "+v"(acc[ai][bj][m][n]) : "v"(Bt##8[n]), "v"(At##8[m]), "v"(scb), "v"(sca)); \
        else { _Pragma("unroll") for (int k = 0; k < 2; ++k) acc[ai][bj][m][n] = __builtin_amdgcn_mfma_f32_16x16x32_bf16(Bt[n][k], At[m][k], acc[ai][bj][m][n], 0, 0, 0); } } \
        __builtin_amdgcn_s_setprio(0); } while (0)
#define PG8_WAIT_V(n) asm volatile("s_waitcnt vmcnt(" #n ")" ::: "memory")
#define PG8_WAIT_L(n) asm volatile("s_waitcnt lgkmcnt(" #n ")" ::: "memory")
#define PG8_BAR __builtin_amdgcn_s_barrier()
#define PG8_SCHED __builtin_amdgcn_sched_barrier(0)
    Unit cur, nxt; int ui = 0;
    if (!S.next(0, cur)) return;
    f32x4 acc[2][2][4][2];
#pragma unroll
    for (int a = 0; a < 2; ++a)
#pragma unroll
        for (int b = 0; b < 2; ++b)
#pragma unroll
            for (int m = 0; m < 4; ++m)
#pragma unroll
                for (int n = 0; n < 2; ++n) acc[a][b][m][n] = (f32x4){0.f, 0.f, 0.f, 0.f};
    int scb = SCALE_B, sca = 127; asm volatile("" : "+v"(scb), "+v"(sca));
    bf16x8 At[4][2], B0[2][2], B1[2][2]; i32x8m At8[4], B08[2], B18[2];
    unsigned cv00 = S.aoff(cur, sR[0], sC[0]), cv01 = S.aoff(cur, sR[1], sC[1]), cv10 = S.aoff(cur, HALF + sR[0], sC[0]), cv11 = S.aoff(cur, HALF + sR[1], sC[1]);
    const char* cA = cur.a; const char* cB = cur.b;
    PG8_STAGEB(PG8_SB(0, 0), cB); PG8_STAGEB(PG8_SB(0, 1), cB + hstepB); PG8_STAGE2(PG8_SA(0, 0), cA, cv00, cv01); PG8_STAGE2(PG8_SA(0, 1), cA, cv10, cv11);
    if (wr == 1) PG8_BAR;
    PG8_WAIT_V(2); PG8_BAR;
    PG8_STAGEB(PG8_SB(1, 0), cB + kstep); PG8_STAGE2(PG8_SA(1, 0), cA + kstep, cv00, cv01); PG8_STAGEB(PG8_SB(1, 1), cB + hstepB + kstep);
    PG8_WAIT_V(6); PG8_BAR;
    for (;;) {
        const bool has_next = S.next(ui + 1, nxt);
        const char* nA = has_next ? nxt.a : cA; const char* nB = has_next ? nxt.b : cB;
        unsigned nv00 = cv00, nv01 = cv01, nv10 = cv10, nv11 = cv11;
        if (Sched::GATHER && has_next && nt < 6) { nv00 = S.aoff(nxt, sR[0], sC[0]); nv01 = S.aoff(nxt, sR[1], sC[1]); nv10 = S.aoff(nxt, HALF + sR[0], sC[0]); nv11 = S.aoff(nxt, HALF + sR[1], sC[1]); }
#pragma nounroll
        for (int t = 0; t < nt; t += 2) {
            const bool last = (t == nt - 2);
            const char* a1 = cA + (size_t)(t + 1) * kstep;
            const char* a2 = last ? nA : cA + (size_t)(t + 2) * kstep; const char* b2 = last ? nB : cB + (size_t)(t + 2) * kstep;
            const char* a3 = a2 + kstep; const char* b3 = b2 + kstep;
            const unsigned x00 = last ? nv00 : cv00, x01 = last ? nv01 : cv01, x10 = last ? nv10 : cv10, x11 = last ? nv11 : cv11;
            PG8_LDB(B0, 0, 0); PG8_LDB(B1, 0, 1); PG8_SCHED; PG8_LDA(At, 0, 0); PG8_STAGE2(PG8_SA(1, 1), a1, cv10, cv11);
            PG8_WAIT_V(8); PG8_WAIT_L(0); PG8_BAR; PG8_MMA(0, 0, At, B0); PG8_MMA(0, 1, At, B1); PG8_BAR; PG8_SCHED;
            PG8_LDA(At, 0, 1); PG8_STAGEB(PG8_SB(0, 0), b2); PG8_STAGEB(PG8_SB(0, 1), b2 + hstepB); PG8_STAGE2(PG8_SA(0, 0), a2, x00, x01);
            PG8_WAIT_V(8); PG8_WAIT_L(0); PG8_BAR; PG8_MMA(1, 0, At, B0); PG8_MMA(1, 1, At, B1); PG8_BAR; PG8_SCHED;
            PG8_LDB(B0, 1, 0); PG8_LDB(B1, 1, 1); PG8_SCHED; PG8_LDA(At, 1, 0); PG8_STAGE2(PG8_SA(0, 1), a2, x10, x11);
            PG8_WAIT_V(8); PG8_WAIT_L(0); PG8_BAR; PG8_MMA(0, 0, At, B0); PG8_MMA(0, 1, At, B1); PG8_BAR; PG8_SCHED;
            PG8_LDA(At, 1, 1); PG8_STAGEB(PG8_SB(1, 0), b3); PG8_STAGEB(PG8_SB(1, 1), b3 + hstepB); PG8_STAGE2(PG8_SA(1, 0), a3, x00, x01);
            PG8_WAIT_V(8); PG8_WAIT_L(0); PG8_BAR; PG8_MMA(1, 0, At, B0); PG8_MMA(1, 1, At, B1); PG8_BAR; PG8_SCHED;
            if (Sched::GATHER && has_next && nt >= 6 && t == nt - 6) { nv00 = S.aoff(nxt, sR[0], sC[0]); nv01 = S.aoff(nxt, sR[1], sC[1]); nv10 = S.aoff(nxt, HALF + sR[0], sC[0]); nv11 = S.aoff(nxt, HALF + sR[1], sC[1]); }
        }
        if constexpr (ALIGN_EPI) { if (wr == 0) PG8_BAR; }
        if constexpr (F8) asm volatile("s_nop 15\n\ts_nop 3" ::: "memory");
        E(acc, cur, wr, wc, fr, fq);
        if (!has_next) break;
#pragma unroll
        for (int a = 0; a < 2; ++a)
#pragma unroll
            for (int b = 0; b < 2; ++b)
#pragma unroll
                for (int m = 0; m < 4; ++m)
#pragma unroll
                    for (int n = 0; n < 2; ++n) acc[a][b][m][n] = (f32x4){0.f, 0.f, 0.f, 0.f};
        cur = nxt; cA = nA; cB = nB; cv00 = nv00; cv01 = nv01; cv10 = nv10; cv11 = nv11; ++ui;
        if constexpr (ALIGN_EPI) { if (wr == 1) PG8_BAR; }
    }
    PG8_WAIT_V(0);
    if constexpr (!ALIGN_EPI) { if (wr == 0) PG8_BAR; }
    PG8_BAR;
#undef PG8_SA
#undef PG8_SB
#undef PG8_STAGE2
#undef PG8_STAGEB
#undef PG8_LDA
#undef PG8_LDB
#undef PG8_MMA
#undef PG8_WAIT_V
#undef PG8_WAIT_L
#undef PG8_BAR
#undef PG8_SCHED
}
}
using pg8::Unit;
using pg8::cvt_pk_bf16;

struct Args { const float* in[27]; float* out; unsigned char* ws; int ph_lo, ph_hi; };
enum { I_X = 0, I_C, I_CTX, I_CCTX, I_ADAW, I_ADAB, I_LNMG, I_LNMB, I_LNFG, I_LNFB, I_WIN, I_SLNG, I_SLNB, I_SWS, I_SBS, I_WOUT, I_WQKV, I_SINK, I_WAO,
       I_RW, I_RB, I_MG, I_MU, I_MD, I_SG, I_SU, I_SD };

struct Frame {
    LAS unsigned char* lds;
    int tid, lane, wave, G, bid;
    unsigned char* ws;
};
__device__ __forceinline__ int modrow(int row) { return row < TC ? 2 : ((row - TC) >> 12); }
__device__ __forceinline__ const float* modp(const unsigned char* ws, int layer, int r, int chunk) { return (const float*)(ws + WS_MOD) + ((size_t)(layer * 3 + r) * 6 + chunk) * D; }

struct ConvJob { const float* src; bf16_t* dst; int K, N, mode; };
__device__ __forceinline__ int rope_pos(int d) { const int half = d >> 6, which = (d >> 5) & 1, f = d & 31; return 32 * (half * 2 + (f >> 4)) + 8 * ((f & 15) >> 2) + 4 * which + (f & 3); }
__device__ __forceinline__ void conv_item8(const float* __restrict__ src, int K, int N, int k0, int n0, unsigned char* dst, int mode, LAS float* scr, int lane) {
    f32x4 ld[16];
#pragma unroll
    for (int i = 0; i < 16; ++i) { const int kr = 8 * i + (lane >> 3), c4 = lane & 7; ld[i] = __builtin_nontemporal_load((const GAS f32x4*)(src + (size_t)(k0 + kr) * N + n0 + 4 * c4)); }
#pragma unroll
    for (int i = 0; i < 16; ++i) { const int kr = 8 * i + (lane >> 3), c4 = lane & 7;
        LAS float* s = scr + kr * 33 + 4 * c4; s[0] = ld[i][0]; s[1] = ld[i][1]; s[2] = ld[i][2]; s[3] = ld[i][3]; }
    LDS_WAIT(); asm volatile("" ::: "memory");
    const int c = lane & 15;
#pragma unroll
    for (int j = 0; j < 8; ++j) { const int nl = 4 * j + (lane >> 4), n = n0 + nl; const LAS float* s = scr + (8 * c) * 33 + nl;
        u32x2 o; o.x = pk4_fp8(32.f * s[0], 32.f * s[33], 32.f * s[2 * 33], 32.f * s[3 * 33]); o.y = pk4_fp8(32.f * s[4 * 33], 32.f * s[5 * 33], 32.f * s[6 * 33], 32.f * s[7 * 33]);
        const int row = mode == 0 ? n : (n >> 7) * 256 + (mode == 3 ? 128 : 0) + (n & 127);
        *(GAS u32x2*)(dst + (size_t)row * K + k0 + 8 * c) = o; }
    LDS_WAIT(); asm volatile("" ::: "memory");
}
__device__ __forceinline__ void conv_item(const float* __restrict__ src, int K, int N, int k0, int n0, bf16_t* dst, int mode, bf16_t* dst_v, LAS float* scr, int lane, bool f8 = false) {
    f32x4 ld[16];
#pragma unroll
    for (int i = 0; i < 16; ++i) { const int kr = 4 * i + (lane >> 4), c4 = lane & 15; ld[i] = __builtin_nontemporal_load((const GAS f32x4*)(src + (size_t)(k0 + kr) * N + n0 + 4 * c4)); }
#pragma unroll
    for (int i = 0; i < 16; ++i) { const int kr = 4 * i + (lane >> 4), c4 = lane & 15;
        LAS float* s = scr + kr * 65 + 4 * c4; s[0] = ld[i][0]; s[1] = ld[i][1]; s[2] = ld[i][2]; s[3] = ld[i][3]; }
    LDS_WAIT(); asm volatile("" ::: "memory");
    const int c = lane & 7;
#pragma unroll
    for (int j = 0; j < 8; ++j) { const int nl = 8 * j + (lane >> 3), n = n0 + nl; const LAS float* s = scr + (8 * c) * 65 + nl;
        if (f8) {
            u32x2 o; o.x = pk4_fp8(32.f * s[0], 32.f * s[65], 32.f * s[2 * 65], 32.f * s[3 * 65]); o.y = pk4_fp8(32.f * s[4 * 65], 32.f * s[5 * 65], 32.f * s[6 * 65], 32.f * s[7 * 65]);
            const int row = mode == 0 ? n : (n >> 7) * 256 + (mode == 3 ? 128 : 0) + (n & 127);
            *(GAS u32x2*)((unsigned char*)dst + (size_t)row * K + k0 + 8 * c) = o; continue; }
        u32x4 o; o.x = pk2(s[0], s[65]); o.y = pk2(s[2 * 65], s[3 * 65]); o.z = pk2(s[4 * 65], s[5 * 65]); o.w = pk2(s[6 * 65], s[7 * 65]);
        bf16_t* drow;
        if (mode == 0) drow = dst + (size_t)n * K;
        else if (mode == 1) { if (n < 2560) drow = dst + (size_t)((n & ~127) + rope_pos(n & 127)) * K; else drow = dst_v + (size_t)(n - 2560) * K; }
        else { const int ntile = n >> 7, r = n & 127; drow = dst + (size_t)(ntile * 256 + (mode == 3 ? 128 : 0) + r) * K; }
        *(GAS u32x4*)(drow + k0 + 8 * c) = o; }
    LDS_WAIT(); asm volatile("" ::: "memory");
}
namespace cv { constexpr int I_A = 32 * 48, I_B = 32 * 32, I_E = 256; constexpr int N0 = I_A, N1 = N0 + I_B, N2 = N1 + I_A, N3 = N2 + I_B, NG = N3 + 130 * I_E, NU = NG + 130 * I_E, ND = NU + 130 * I_E, HALFM = 65 * I_E; }
constexpr int CW_QHEAD = 2048;
static __device__ __forceinline__ void conv_impl(LAS unsigned char* lds, unsigned char* ws, const float* win, const float* wout, const float* wqkv, const float* wao, const float* mg, const float* mu, const float* md,
                                       const float* sg, const float* su, const float* sd, int it_lo, int it_hi, int gw, int NGW, unsigned* qhead, int quota) {
    using namespace cv;
    const int lane = threadIdx.x & 63, wave = threadIdx.x >> 6;
    LAS float* scr = (LAS float*)(lds + wave * 16896);
    int it0 = it_lo + gw; bool deferred = false;
    if (qhead) { deferred = true;
        if (quota >= 0) { unsigned d = 0u; if (lane == 0) d = __hip_atomic_fetch_add(qhead, (unsigned)quota, __ATOMIC_RELAXED, __HIP_MEMORY_SCOPE_AGENT);
            it0 = __builtin_amdgcn_readfirstlane((int)d); it_hi = it0 + quota; NGW = 1; }
        else { const unsigned h = __hip_atomic_load(qhead, __ATOMIC_RELAXED, __HIP_MEMORY_SCOPE_AGENT); it0 = (int)h + gw; }
        if (it_hi > 4 * HALFM) it_hi = 4 * HALFM; }
    for (;;) {
        if (it0 >= it_hi) break;
        int it = it0; it0 += NGW;
        if (deferred) it = it < HALFM ? NU + it : it < 2 * HALFM ? N3 + it : it < 3 * HALFM ? NG + it - HALFM : NU + it - 2 * HALFM;
        const float* src; bf16_t* dst; bf16_t* dstv = nullptr; int K, N, mode, r; bool f8 = false;
        if (it < N0) { r = it; src = win; dst = (bf16_t*)(ws + WS_WIN); K = 2048; N = 3072; mode = 0; }
        else if (it < N1) { r = it - N0; src = wout; dst = (bf16_t*)(ws + WS_WOUT); K = 2048; N = 2048; mode = 0; }
        else if (it < N2) { r = it - N1; src = wqkv; dst = (bf16_t*)(ws + WS_WQK); dstv = (bf16_t*)(ws + WS_WV); K = 2048; N = 3072; mode = 1; }
        else if (it < N3) { r = it - N2; src = wao; dst = (bf16_t*)(ws + WS_WAO); K = 2048; N = 2048; mode = 0; }
        else {
            int cls, q; if (it < NG) { cls = 0; q = it - N3; } else if (it < NU) { cls = 1; q = it - NG; } else { cls = 2; q = it - NU; }
            const int mat = q / I_E; r = q % I_E; const int layer = mat / 65, e = mat % 65;
            if (cls < 2) { K = 2048; N = 512; mode = 2 + cls;
                src = (e < 64) ? (cls == 0 ? mg : mu) + ((size_t)(layer * 64 + e)) * 2048 * 512 : (cls == 0 ? sg : su) + (size_t)layer * 2048 * 512;
                dst = (bf16_t*)(ws + WS_WGU + layer * WGU8_L + e * WGU8_E); f8 = true; }
            else { K = 512; N = 2048; mode = 0;
                src = (e < 64) ? md + ((size_t)(layer * 64 + e)) * 512 * 2048 : sd + (size_t)layer * 512 * 2048;
                dst = (bf16_t*)(ws + WS_WD + layer * WD8_L + e * WD8_E); f8 = true; }
        }
        if (f8) { const int nb = N / 32, kb = r / nb, nbi = r % nb; conv_item8(src, K, N, kb * 128, nbi * 32, (unsigned char*)dst, mode, scr, lane); }
        else { const int nb = N / 64, kb = r / nb, nbi = r % nb; conv_item(src, K, N, kb * 64, nbi * 64, dst, mode, dstv, scr, lane, false); }
    }
}
__device__ __forceinline__ void conv_range(const Frame& F, const Args& a, int it_lo, int it_hi) {
    conv_impl(F.lds, F.ws, a.in[I_WIN], a.in[I_WOUT], a.in[I_WQKV], a.in[I_WAO], a.in[I_MG], a.in[I_MU], a.in[I_MD], a.in[I_SG], a.in[I_SU], a.in[I_SD], it_lo, it_hi, F.bid * NWAVES + F.wave, F.G * NWAVES, nullptr, 0);
}
__device__ __forceinline__ void conv_pull(const Frame& F, const Args& a, int quota) {
    if (quota > 0) conv_impl(F.lds, F.ws, a.in[I_WIN], a.in[I_WOUT], a.in[I_WQKV], a.in[I_WAO], a.in[I_MG], a.in[I_MU], a.in[I_MD], a.in[I_SG], a.in[I_SU], a.in[I_SD], 0, 0, 0, 1, (unsigned*)(F.ws + WS_CTL) + CW_QHEAD, quota);
}
__device__ __forceinline__ void conv_cleanup(const Frame& F, const Args& a, int upto) {
    conv_impl(F.lds, F.ws, a.in[I_WIN], a.in[I_WOUT], a.in[I_WQKV], a.in[I_WAO], a.in[I_MG], a.in[I_MU], a.in[I_MD], a.in[I_SG], a.in[I_SU], a.in[I_SD], 0, upto, F.bid * NWAVES + F.wave, F.G * NWAVES, (unsigned*)(F.ws + WS_CTL) + CW_QHEAD, -1);
}
__device__ __forceinline__ void p0_mod(const Frame& F, const Args& a) {
    LAS float* sv = (LAS float*)F.lds;
    LAS float* red = (LAS float*)(F.lds + 32768);
    for (int i = F.tid; i < 3 * D; i += NTHREADS) { const int r = i / D, k = i % D; const float v = r < 2 ? a.in[I_C][r * D + k] : a.in[I_CCTX][k]; sv[i] = silu_f(v); }
    __syncthreads();
    float* mod = (float*)(F.ws + WS_MOD);
    for (int u = F.bid; u < 256; u += F.G) {
        const int layer = u >> 7, n0 = (u & 127) * 96;
        const float* W = a.in[I_ADAW] + (size_t)layer * D * 12288;
        const int kq = F.lane / 24, c4 = F.lane % 24; const bool act = F.lane < 48;
        f32x4 acc[3] = {{0.f, 0.f, 0.f, 0.f}, {0.f, 0.f, 0.f, 0.f}, {0.f, 0.f, 0.f, 0.f}};
        if (act) {
#pragma unroll 8
            for (int it = 0; it < 128; ++it) { const int k = F.wave * 256 + it * 2 + kq;
                const f32x4 w = __builtin_nontemporal_load((const GAS f32x4*)(W + (size_t)k * 12288 + n0 + 4 * c4));
#pragma unroll
                for (int r = 0; r < 3; ++r) acc[r] += w * sv[r * D + k]; } }
#pragma unroll
        for (int r = 0; r < 3; ++r)
#pragma unroll
            for (int j = 0; j < 4; ++j) { const float o = __shfl(acc[r][j], (F.lane + 24) & 63); if (F.lane < 24) red[(F.wave * 3 + r) * 96 + 4 * c4 + j] = acc[r][j] + o; }
        __syncthreads();
        if (F.tid < 288) { const int r = F.tid / 96, cidx = F.tid % 96; float s = 0.f;
#pragma unroll
            for (int w = 0; w < 8; ++w) s += red[(w * 3 + r) * 96 + cidx];
            mod[(size_t)(layer * 3 + r) * 12288 + n0 + cidx] = s + a.in[I_ADAB][layer * 12288 + n0 + cidx]; }
        __syncthreads();
    }
}
__device__ __forceinline__ void p0_tables(const Frame& F, const float* rwsrc) {
    bf16_t* wct = (bf16_t*)(F.ws + WS_WCT); bf16_t* t256 = (bf16_t*)(F.ws + WS_T256); f32x2* rope = (f32x2*)(F.ws + WS_ROPE);
    const int gt = F.bid * NTHREADS + F.tid, NGT = F.G * NTHREADS;
    for (int i = gt; i < 256 * 256; i += NGT) { const int m = i >> 8, c = i & 255, j = (m * c) & 255;
        const float cs = cospif((float)j * (1.0f / 128.0f)), sn = sinpif((float)j * (1.0f / 128.0f));
        wct[(2 * m) * 256 + c] = (bf16_t)f2bf(cs); wct[(2 * m + 1) * 256 + c] = (bf16_t)f2bf(-sn);
        t256[m * 512 + c] = (bf16_t)f2bf(cs); t256[m * 512 + 256 + c] = (bf16_t)f2bf(sn); }
    for (int i = gt; i < 2 * D * NEXP; i += NGT) { const int layer = i / (D * NEXP), k = (i / NEXP) % D, e = i % NEXP; const float w = rwsrc[i];
        const unsigned hi = f2bf(w); const float lo = w - __builtin_bit_cast(float, hi << 16);
        ((bf16_t*)(F.ws + WS_RWH))[(size_t)(layer * NEXP + e) * D + k] = (bf16_t)hi; ((bf16_t*)(F.ws + WS_RWL))[(size_t)(layer * NEXP + e) * D + k] = (bf16_t)f2bf(lo); }
    for (int i = gt; i < 64 * 32; i += NGT) { const int id = i >> 5, f = i & 31;
        const double inv = pow(10000.0, -(double)f / 32.0); const double ang = (double)id * (double)(float)inv;
        rope[i] = (f32x2){(float)cos(ang), (float)sin(ang)}; }
}

__device__ __forceinline__ void phase_modulate0(const Frame& F, const Args& a) {
    bf16_t* A0 = (bf16_t*)(F.ws + WS_A0);
    const int gw = F.bid * NWAVES + F.wave, NGW = F.G * NWAVES;
    for (int row = gw; row < T0; row += NGW) {
        const float* src = row < TC ? a.in[I_CTX] + (size_t)row * D : a.in[I_X] + (size_t)(row - TC) * D;
        const int r = modrow(row); const float* sh = modp(F.ws, 0, r, 0); const float* sc = modp(F.ws, 0, r, 1);
#pragma unroll
        for (int j = 0; j < 8; ++j) { const int c = 4 * F.lane + 256 * j;
            const f32x4 v = *(const GAS f32x4*)(src + c), s = *(const GAS f32x4*)(sc + c), h = *(const GAS f32x4*)(sh + c);
            const f32x4 o = v * (s + 1.0f) + h; u32x2 w; w.x = pk2(o[0], o[1]); w.y = pk2(o[2], o[3]);
            *(GAS u32x2*)(A0 + (size_t)row * D + c) = w; }
    }
}

__device__ __forceinline__ void phase_butterfly(const Frame& F) {
    LAS f32x2* tw = (LAS f32x2*)F.lds;
    for (int j = F.tid; j < 4096; j += NTHREADS) { const float x = (float)j * (1.0f / 2048.0f); tw[j] = (f32x2){cospif(x), sinpif(x)}; }
    __syncthreads();
    const bf16_t* Yt = (const bf16_t*)(F.ws + WS_YTL); bf16_t* Gt = (bf16_t*)(F.ws + WS_GT);
    for (int item = F.bid * NTHREADS + F.tid; item < 2 * 1024 * 64; item += F.G * NTHREADS) {
        const int lq = item & 63, n = (item >> 6) & 1023, b = item >> 16, l1 = 4 * lq;
        const bf16_t* yre = Yt + ((size_t)(b * 1024 + n) * 2 + 0) * 4096 + l1; const bf16_t* yim = yre + 4096;
        float are[16][4], aim[16][4];
#pragma unroll
        for (int l2 = 0; l2 < 16; ++l2) { const u32x2 p = *(const GAS u32x2*)(yre + 256 * l2), q = *(const GAS u32x2*)(yim + 256 * l2);
            are[l2][0] = bflo(p.x); are[l2][1] = bfhi(p.x); are[l2][2] = bflo(p.y); are[l2][3] = bfhi(p.y);
            aim[l2][0] = bflo(q.x); aim[l2][1] = bfhi(q.x); aim[l2][2] = bflo(q.y); aim[l2][3] = bfhi(q.y); }
        for (int r = 0; r < 16; ++r) {
            float sre[4] = {0.f, 0.f, 0.f, 0.f}, sim[4] = {0.f, 0.f, 0.f, 0.f};
#pragma unroll
            for (int l2 = 0; l2 < 16; ++l2) { const f32x2 cs = tw[((l2 * r) & 15) * 256];
#pragma unroll
                for (int e = 0; e < 4; ++e) { sre[e] += are[l2][e] * cs.x + aim[l2][e] * cs.y; sim[e] += aim[l2][e] * cs.x - are[l2][e] * cs.y; } }
            float gre[4], gim[4];
#pragma unroll
            for (int e = 0; e < 4; ++e) { const f32x2 cs = tw[((l1 + e) * r) & 4095]; gre[e] = sre[e] * cs.x + sim[e] * cs.y; gim[e] = sim[e] * cs.x - sre[e] * cs.y; }
            bf16_t* g = Gt + ((size_t)((b * 16 + r) * 1024 + n) * 2) * 256 + l1;
            u32x2 w; w.x = pk2(gre[0], gre[1]); w.y = pk2(gre[2], gre[3]); *(GAS u32x2*)g = w;
            w.x = pk2(gim[0], gim[1]); w.y = pk2(gim[2], gim[3]); *(GAS u32x2*)(g + 256) = w;
        }
    }
}

struct DenseSched {
    static constexpr bool GATHER = false;
    const char* A; const char* B; int lda, ldb, nM, nN, G, c;
    __device__ __forceinline__ bool next(int i, Unit& u) const { const int L = i * G + c; if (c >= G || L >= nM * nN) return false; int pm, pn; pg8::tile_order(L, nM, nN, pm, pn);
        u.a = A + (size_t)pm * 256 * lda * 2; u.b = B + (size_t)pn * 256 * ldb * 2; u.i0 = pm; u.i1 = pn; u.i2 = 0; u.i3 = 0; return true; }
    __device__ __forceinline__ unsigned aoff(const Unit&, int R, int C) const { return (unsigned)(R * lda + C) * 2u; }
};
struct EpiWin { static constexpr bool PERM = true; bf16_t* Z;
    __device__ __forceinline__ void operator()(const f32x4 (&acc)[2][2][4][2], const Unit& u, int wr, int wc, int fr, int fq) const {
        const int row0 = u.i0 * 256 + wr * 64 + fr, col0 = u.i1 * 256 + wc * 32 + 8 * fq; const bool act = u.i1 >= 4;
#pragma unroll
        for (int ai = 0; ai < 2; ++ai)
#pragma unroll
            for (int m = 0; m < 4; ++m) { bf16_t* rowp = Z + (size_t)(row0 + ai * 128 + m * 16) * 3072 + col0;
#pragma unroll
                for (int bj = 0; bj < 2; ++bj) { f32x4 v0 = acc[ai][bj][m][0], v1 = acc[ai][bj][m][1];
                    if (act) {
#pragma unroll
                        for (int j = 0; j < 4; ++j) { v0[j] = gelu_tanh(v0[j]); v1[j] = gelu_tanh(v1[j]); } }
                    u32x4 w; w.x = cvt_pk_bf16(v0[0], v0[1]); w.y = cvt_pk_bf16(v0[2], v0[3]); w.z = cvt_pk_bf16(v1[0], v1[1]); w.w = cvt_pk_bf16(v1[2], v1[3]);
                    *(GAS u32x4*)(rowp + bj * 128) = w; } }
    }
};
struct EpiResid { static constexpr bool PERM = true; bf16_t* X; const float* rx; const float* rctx; const unsigned char* ws; int layer, rowbase;
    __device__ __forceinline__ void operator()(const f32x4 (&acc)[2][2][4][2], const Unit& u, int wr, int wc, int fr, int fq) const {
        const int row0 = rowbase + u.i0 * 256 + wr * 64 + fr, col0 = u.i1 * 256 + wc * 32 + 8 * fq;
        const float* g1 = modp(ws, layer, modrow(rowbase + u.i0 * 256), 2) + col0;
        f32x4 gv[2][2];
#pragma unroll
        for (int bj = 0; bj < 2; ++bj)
#pragma unroll
            for (int n = 0; n < 2; ++n) gv[bj][n] = *(const GAS f32x4*)(g1 + bj * 128 + n * 4);
#pragma unroll
        for (int ai = 0; ai < 2; ++ai)
#pragma unroll
            for (int m = 0; m < 4; ++m) { const int row = row0 + ai * 128 + m * 16; bf16_t* op = X + (size_t)row * D + col0;
#pragma unroll
                for (int bj = 0; bj < 2; ++bj) { f32x4 r0, r1;
                    if (layer == 0) { const float* rp = (row < TC ? rctx + (size_t)row * D : rx + (size_t)(row - TC) * D) + col0 + bj * 128; r0 = *(const GAS f32x4*)rp; r1 = *(const GAS f32x4*)(rp + 4); }
                    else { const u32x4 p = *(const GAS u32x4*)(op + bj * 128); r0 = (f32x4){bflo(p.x), bfhi(p.x), bflo(p.y), bfhi(p.y)}; r1 = (f32x4){bflo(p.z), bfhi(p.z), bflo(p.w), bfhi(p.w)}; }
                    const f32x4 v0 = r0 * ALPHA + gv[bj][0] * acc[ai][bj][m][0], v1 = r1 * ALPHA + gv[bj][1] * acc[ai][bj][m][1];
                    u32x4 w; w.x = cvt_pk_bf16(v0[0], v0[1]); w.y = cvt_pk_bf16(v0[2], v0[3]); w.z = cvt_pk_bf16(v1[0], v1[1]); w.w = cvt_pk_bf16(v1[2], v1[3]);
                    *(GAS u32x4*)(op + bj * 128) = w; } }
    }
};
struct EpiBf16G { static constexpr bool PERM = true; bf16_t* O0; bf16_t* O1; int ldc0, ldc1; float sc0, sc1;
    __device__ __forceinline__ void operator()(const f32x4 (&acc)[2][2][4][2], const Unit& u, int wr, int wc, int fr, int fq) const {
        bf16_t* O = u.i3 ? O1 : O0; const int ldc = u.i3 ? ldc1 : ldc0; const float sc = u.i3 ? sc1 : sc0; const int rs = u.i1;
        const int r0 = wr * 64 + fr, col0 = u.i2 + wc * 32 + 8 * fq;
#pragma unroll
        for (int ai = 0; ai < 2; ++ai)
#pragma unroll
            for (int m = 0; m < 4; ++m) { bf16_t* rowp = O + (size_t)(u.i0 + rs * (r0 + ai * 128 + m * 16)) * ldc + col0;
#pragma unroll
                for (int bj = 0; bj < 2; ++bj) { const f32x4 v0 = acc[ai][bj][m][0] * sc, v1 = acc[ai][bj][m][1] * sc;
                    u32x4 w; w.x = cvt_pk_bf16(v0[0], v0[1]); w.y = cvt_pk_bf16(v0[2], v0[3]); w.z = cvt_pk_bf16(v1[0], v1[1]); w.w = cvt_pk_bf16(v1[2], v1[3]);
                    *(GAS u32x4*)(rowp + bj * 128) = w; } }
    }
};
struct EpiYs8 { static constexpr int PERM = 2; unsigned char* YS;
    __device__ __forceinline__ void operator()(const f32x4 (&acc)[2][2][4][2], const Unit& u, int wr, int wc, int fr, int fq) const {
        const int r0 = wr * 64 + fr, col0 = u.i2 + wc * 64 + 16 * fq;
#pragma unroll
        for (int ai = 0; ai < 2; ++ai)
#pragma unroll
            for (int m = 0; m < 4; ++m) { unsigned char* rowp = YS + (size_t)(u.i0 + r0 + ai * 128 + m * 16) * D + col0;
                const f32x4 v00 = acc[ai][0][m][0] * 16.0f, v01 = acc[ai][0][m][1] * 16.0f, v10 = acc[ai][1][m][0] * 16.0f, v11 = acc[ai][1][m][1] * 16.0f;
                u32x4 w; w.x = pk4_fp8(v00[0], v00[1], v00[2], v00[3]); w.y = pk4_fp8(v01[0], v01[1], v01[2], v01[3]); w.z = pk4_fp8(v10[0], v10[1], v10[2], v10[3]); w.w = pk4_fp8(v11[0], v11[1], v11[2], v11[3]);
                *(GAS u32x4*)rowp = w; }
    }
};
struct Dft1Sched { static constexpr bool GATHER = false; const unsigned char* ws; int G, c;
    __device__ __forceinline__ bool next(int i, Unit& u) const { const int L = i * G + c; if (L >= 272) return false;
        int bg, mt, ntile, isctx; if (L < 256) { bg = L >> 5; mt = (L >> 4) & 1; ntile = L & 15; isctx = 0; } else { const int v = L - 256; bg = v >> 1; mt = v & 1; ntile = 0; isctx = 1; }
        const int b = bg >> 2, g = bg & 3, rowbase = isctx ? b * CTXL : TC + b * SEQ;
        u.a = (const char*)(ws + WS_WCT) + (size_t)mt * 256 * 256 * 2; u.b = (const char*)(ws + WS_Z) + ((size_t)(rowbase + ntile * 256) * 3072 + g * 256) * 2;
        u.i0 = bg * 512 + mt * 256; u.i1 = 1; u.i2 = ntile * 256; u.i3 = isctx; return true; }
    __device__ __forceinline__ unsigned aoff(const Unit&, int R, int C) const { return (unsigned)(R * 256 + C) * 2u; }
};
struct Dft2Sched { static constexpr bool GATHER = false; const unsigned char* ws; int G, c;
    __device__ __forceinline__ bool next(int i, Unit& u) const { const int L = i * G + c; if (L >= 136) return false;
        u.a = (const char*)(ws + WS_T256); u.i2 = (L & 3) * 256;
        if (L < 128) { const int b = L >> 6, r = (L >> 2) & 15, nt = L & 3; u.b = (const char*)(ws + WS_GT) + ((size_t)((b * 16 + r) * 1024 + nt * 256) * 512) * 2; u.i0 = TC + b * SEQ + r; u.i1 = 16; u.i3 = 0; }
        else { const int v = L - 128, b = v >> 2, nt = v & 3; u.b = (const char*)(ws + WS_YTC) + ((size_t)(b * 1024 + nt * 256) * 512) * 2; u.i0 = b * CTXL; u.i1 = 1; u.i3 = 1; }
        return true; }
    __device__ __forceinline__ unsigned aoff(const Unit&, int R, int C) const { return (unsigned)(R * 512 + C) * 2u; }
};
struct QkvSched { static constexpr bool GATHER = false; const unsigned char* ws; int G, c;
    __device__ __forceinline__ bool next(int i, Unit& u) const { const int L = i * G + c; if (L >= 392) return false;
        const char* A0 = (const char*)(ws + WS_A0);
        if (L < 324) { int pm, pn; if (L < 320) { pg8::tile_order(L, 32, 10, pm, pn); pm += 2; } else { pm = (L - 320) >> 1; pn = 8 + ((L - 320) & 1); }
            u.a = A0 + (size_t)pm * 256 * D * 2; u.b = (const char*)(ws + WS_WQK) + (size_t)pn * 256 * D * 2; u.i0 = pm * 256; u.i1 = pn; u.i2 = 0; u.i3 = 0; }
        else { const int v = L - 324, mt = v & 1, ntile = v >> 1;
            u.a = (const char*)(ws + WS_WV) + (size_t)mt * 256 * D * 2; u.b = A0 + (size_t)ntile * 256 * D * 2; u.i0 = mt * 256; u.i1 = ntile; u.i2 = 1; u.i3 = 0; }
        return true; }
    __device__ __forceinline__ unsigned aoff(const Unit&, int R, int C) const { return (unsigned)(R * D + C) * 2u; }
};
struct EpiQkv { static constexpr bool PERM = true; bf16_t* QK; bf16_t* VT; const f32x2* rope;
    __device__ __forceinline__ void operator()(const f32x4 (&acc)[2][2][4][2], const Unit& u, int wr, int wc, int fr, int fq) const {
        const int r0 = u.i0 + wr * 64 + fr;
        if (u.i2) {
            const int col0 = u.i1 * 256 + wc * 32 + 8 * fq;
#pragma unroll
            for (int ai = 0; ai < 2; ++ai)
#pragma unroll
                for (int m = 0; m < 4; ++m) { bf16_t* rowp = VT + (size_t)(r0 + ai * 128 + m * 16) * T0 + col0;
#pragma unroll
                    for (int bj = 0; bj < 2; ++bj) { const f32x4 v0 = acc[ai][bj][m][0], v1 = acc[ai][bj][m][1];
                        u32x4 w; w.x = cvt_pk_bf16(v0[0], v0[1]); w.y = cvt_pk_bf16(v0[2], v0[3]); w.z = cvt_pk_bf16(v1[0], v1[1]); w.w = cvt_pk_bf16(v1[2], v1[3]);
                        *(GAS u32x4*)(rowp + bj * 128) = w; } }
            return; }
        const int col0 = u.i1 * 256 + wc * 32 + 8 * fq; const float qs = u.i1 < 8 ? QSCALE : 1.0f; const bool dorope = u.i0 >= TC;
        const int half = wc >> 1, f0 = (wc & 1) * 16 + fq * 4;
#pragma unroll
        for (int ai = 0; ai < 2; ++ai)
#pragma unroll
            for (int m = 0; m < 4; ++m) { const int row = r0 + ai * 128 + m * 16; bf16_t* rowp = QK + (size_t)row * 2560 + col0;
                f32x4 cs0 = {1.f, 0.f, 1.f, 0.f}, cs1 = {1.f, 0.f, 1.f, 0.f};
                if (dorope) { const int s = (row - TC) & (SEQ - 1), id = half ? (s & 63) : (s >> 6); const GAS f32x4* rp = (const GAS f32x4*)(rope + id * 32 + f0); cs0 = rp[0]; cs1 = rp[1]; }
#pragma unroll
                for (int bj = 0; bj < 2; ++bj) { const f32x4 x1 = acc[ai][bj][m][0], x2 = acc[ai][bj][m][1]; f32x4 o1, o2;
                    o1[0] = x1[0] * cs0[0] - x2[0] * cs0[1]; o2[0] = x2[0] * cs0[0] + x1[0] * cs0[1];
                    o1[1] = x1[1] * cs0[2] - x2[1] * cs0[3]; o2[1] = x2[1] * cs0[2] + x1[1] * cs0[3];
                    o1[2] = x1[2] * cs1[0] - x2[2] * cs1[1]; o2[2] = x2[2] * cs1[0] + x1[2] * cs1[1];
                    o1[3] = x1[3] * cs1[2] - x2[3] * cs1[3]; o2[3] = x2[3] * cs1[2] + x1[3] * cs1[3];
                    o1 = o1 * qs; o2 = o2 * qs;
                    u32x4 w; w.x = cvt_pk_bf16(o1[0], o1[1]); w.y = cvt_pk_bf16(o1[2], o1[3]); w.z = cvt_pk_bf16(o2[0], o2[1]); w.w = cvt_pk_bf16(o2[2], o2[3]);
                    *(GAS u32x4*)(rowp + bj * 128) = w; } }
    }
};
typedef int i32x4 __attribute__((ext_vector_type(4)));
__device__ __forceinline__ void moe_tables(const Frame& F, int NT, int G, bool spare) {
    LAS int* tb = (LAS int*)(F.lds + MISC_OFF);
    LAS i32x4* ut = (LAS i32x4*)(F.lds + MISC_OFF + 1152);
    if (F.tid == 0) { const int* st = (const int*)(F.ws + WS_EXPT); const int* cn = st + 128; int cc = 0;
        for (int e = 0; e < NE1; ++e) { const int t = (cn[e] + 255) >> 8; tb[e] = cc; tb[66 + e] = t; tb[132 + e] = st[e]; cc += t * NT; }
        tb[65] = cc;
        int geff = G, c = (G % 8 == 0) ? (F.bid % 8) * (G / 8) + F.bid / 8 : F.bid, isconv = 0;
        if (spare && G == 256 && cc > 0) { const int rounds = (cc + G - 1) / G; geff = (cc + rounds - 1) / rounds; const int d = G - geff, x = F.bid & 7, li = F.bid >> 3;
            const int dx = d / 8 + (x < d % 8 ? 1 : 0); isconv = li >= 32 - dx; c = x * 32 - (x * (d / 8) + (x < d % 8 ? x : d % 8)) + li; }
        tb[202] = isconv; tb[200] = geff; tb[201] = c; }
    __syncthreads();
    if (F.tid < 32) { const int geff = tb[200], c = tb[201]; const int L = F.tid * geff + c; i32x4 v = {0, 0, 0, 0};
        if (!tb[202] && L < tb[65]) { int e = 0; while (L >= tb[e + 1]) ++e;
            const int rem = L - tb[e], t = tb[66 + e], mt = rem % t, nt = rem / t; v = (i32x4){e, tb[132 + e] + mt * 256, nt, 1}; }
        ut[F.tid] = v; }
    __syncthreads();
}
__device__ __forceinline__ bool moe_short(const Frame& F) { const LAS int* tb = (const LAS int*)(F.lds + MISC_OFF); const int total = tb[65], geff = tb[200], c = tb[201]; const int mx = (total + geff - 1) / geff; const int mine = total > c ? (total - c - 1) / geff + 1 : 0; return !tb[202] && mine < mx; }
__device__ __forceinline__ bool moe_conv(const Frame& F) { return ((const LAS int*)(F.lds + MISC_OFF))[202] != 0; }
struct MoeSched { static constexpr bool GATHER = true;
    const unsigned char* ws; LAS i32x4* ut; const int* slot_tok; int layer;
    __device__ __forceinline__ bool next(int i, Unit& u) const { if (i >= 32) return false; const i32x4 v = ut[i]; if (!v[3]) return false;
        u.a = (const char*)(ws + WS_A0); u.b = (const char*)(ws + WS_WGU) + (size_t)layer * WGU8_L + (size_t)v[0] * WGU8_E + (size_t)v[2] * 256 * D;
        u.i0 = v[1]; u.i1 = v[2]; u.i2 = v[0]; u.i3 = 0; return true; }
    __device__ __forceinline__ unsigned aoff(const Unit& u, int R, int C) const { return (unsigned)(slot_tok[u.i0 + R] * (D / 2) + C) * 2u; }
};
struct EpiGateUp { static constexpr bool PERM = true; bf16_t* ACT;
    __device__ __forceinline__ void operator()(const f32x4 (&acc)[2][2][4][2], const Unit& u, int wr, int wc, int fr, int fq) const {
        const int r0 = u.i0 + wr * 64 + fr, col0 = u.i1 * 128 + wc * 32 + 8 * fq;
#pragma unroll
        for (int ai = 0; ai < 2; ++ai)
#pragma unroll
            for (int m = 0; m < 4; ++m) { f32x4 h0, h1;
#pragma unroll
                for (int j = 0; j < 4; ++j) { h0[j] = silu_f(acc[ai][0][m][0][j]) * acc[ai][1][m][0][j]; h1[j] = silu_f(acc[ai][0][m][1][j]) * acc[ai][1][m][1][j]; }
                u32x2 w; w.x = pk4_fp8(h0[0], h0[1], h0[2], h0[3]); w.y = pk4_fp8(h1[0], h1[1], h1[2], h1[3]);
                *(GAS u32x2*)((unsigned char*)ACT + (size_t)(r0 + ai * 128 + m * 16) * EDIM + col0) = w; }
    }
};
struct MoeDownSched { static constexpr bool GATHER = false; const unsigned char* ws; LAS i32x4* ut; int layer;
    __device__ __forceinline__ bool next(int i, Unit& u) const { if (i >= 32) return false; const i32x4 v = ut[i]; if (!v[3]) return false;
        u.a = (const char*)(ws + WS_ACT) + (size_t)v[1] * EDIM; u.b = (const char*)(ws + WS_WD) + (size_t)layer * WD8_L + (size_t)v[0] * WD8_E + (size_t)v[2] * 256 * EDIM;
        u.i0 = v[1]; u.i1 = 1; u.i2 = v[2] * 256; u.i3 = 0; return true; }
    __device__ __forceinline__ unsigned aoff(const Unit&, int R, int C) const { return (unsigned)(R * (EDIM / 2) + C) * 2u; }
};

__device__ __forceinline__ void phase_sgu(const Frame& F, const Args& a) {
    LAS bf16_t* wA = (LAS bf16_t*)F.lds;
    LAS bf16_t* vT = (LAS bf16_t*)(F.lds + 34816);
    const bf16_t* Z = (const bf16_t*)(F.ws + WS_Z); bf16_t* MIX = (bf16_t*)(F.ws + WS_MIX);
    const int fr = F.lane & 15, fq = F.lane >> 4;
    for (int rnd = 0;; ++rnd) { const int unit = (F.G != 256) ? F.bid + rnd * F.G : rnd == 0 ? F.bid : (rnd == 1 && F.bid >= 16 && F.bid < 32) ? 256 + F.bid - 16 : (1 << 20); if (unit >= 272) break;
        const int chunk = unit >> 2, g = unit & 3, r0 = chunk * 128;
        const float* wsrc = a.in[I_SWS] + (size_t)g * 128 * 128;
#pragma unroll
        for (int i = 0; i < 8; ++i) { const int idx = F.tid + 512 * i, p = idx >> 5, q4 = idx & 31; const f32x4 v = *(const GAS f32x4*)(wsrc + p * 128 + 4 * q4);
            u32x2 w; w.x = pk2(v[0], v[1]); w.y = pk2(v[2], v[3]); *(LAS u32x2*)(wA + p * 136 + 4 * q4) = w; }
        { const int rg = F.tid >> 5, c8 = F.tid & 31; const int cb = g * 256 + 8 * c8;
          const f32x4 lg0 = *(const GAS f32x4*)(a.in[I_SLNG] + cb), lg1 = *(const GAS f32x4*)(a.in[I_SLNG] + cb + 4), lb0 = *(const GAS f32x4*)(a.in[I_SLNB] + cb), lb1 = *(const GAS f32x4*)(a.in[I_SLNB] + cb + 4);
#pragma unroll 2
          for (int pass = 0; pass < 8; ++pass) { const int q = pass * 16 + rg;
            const u32x4 raw = *(const GAS u32x4*)(Z + (size_t)(r0 + q) * 3072 + 2048 + cb);
            float x[8] = {bflo(raw.x), bfhi(raw.x), bflo(raw.y), bfhi(raw.y), bflo(raw.z), bfhi(raw.z), bflo(raw.w), bfhi(raw.w)};
            float s = 0.f;
#pragma unroll
            for (int i = 0; i < 8; ++i) s += x[i];
#pragma unroll
            for (int o = 1; o < 32; o <<= 1) s += __shfl_xor(s, o);
            const float mean = s * (1.0f / 256.0f); float ss = 0.f;
#pragma unroll
            for (int i = 0; i < 8; ++i) { x[i] -= mean; ss += x[i] * x[i]; }
#pragma unroll
            for (int o = 1; o < 32; o <<= 1) ss += __shfl_xor(ss, o);
            const float rstd = rsqrtf(ss * (1.0f / 256.0f) + LN_EPS);
#pragma unroll
            for (int i = 0; i < 8; ++i) { const float gg = i < 4 ? lg0[i & 3] : lg1[i & 3], bb = i < 4 ? lb0[i & 3] : lb1[i & 3];
                vT[(8 * c8 + i) * 136 + (q ^ ((c8 & 15) << 3))] = (bf16_t)f2bf(x[i] * rstd * gg + bb); } } }
        __syncthreads();
        const int pm = F.wave & 1, cn = F.wave >> 1;
        f32x4 acc[4][4];
#pragma unroll
        for (int m = 0; m < 4; ++m)
#pragma unroll
            for (int n = 0; n < 4; ++n) acc[m][n] = (f32x4){0.f, 0.f, 0.f, 0.f};
#pragma unroll
        for (int kk = 0; kk < 4; ++kk) { bf16x8 am[4], bn[4];
#pragma unroll
            for (int m = 0; m < 4; ++m) am[m] = *(const LAS bf16x8*)(wA + (64 * pm + 16 * m + fr) * 136 + 32 * kk + 8 * fq);
#pragma unroll
            for (int n = 0; n < 4; ++n) { const int cr = 64 * cn + 16 * n + fr; bn[n] = *(const LAS bf16x8*)(vT + cr * 136 + ((32 * kk + 8 * fq) ^ (((cr >> 3) & 15) << 3))); }
#pragma unroll
            for (int m = 0; m < 4; ++m)
#pragma unroll
                for (int n = 0; n < 4; ++n) acc[m][n] = __builtin_amdgcn_mfma_f32_16x16x32_bf16(bn[n], am[m], acc[m][n], 0, 0, 0); }
#pragma unroll
        for (int m = 0; m < 4; ++m) { const int p = 64 * pm + 16 * m + fr, row = r0 + p; const float bias = a.in[I_SBS][g * 128 + p];
#pragma unroll
            for (int n = 0; n < 4; ++n) { const int c = g * 256 + 64 * cn + 16 * n + 4 * fq;
                const u32x2 uu = *(const GAS u32x2*)(Z + (size_t)row * 3072 + 1024 + c);
                const float s0 = bflo(uu.x) * (acc[m][n][0] + bias), s1 = bfhi(uu.x) * (acc[m][n][1] + bias), s2 = bflo(uu.y) * (acc[m][n][2] + bias), s3 = bfhi(uu.y) * (acc[m][n][3] + bias);
                u32x2 w; w.x = pk2(s0, s1); w.y = pk2(s2, s3); *(GAS u32x2*)(MIX + (size_t)row * D + 1024 + c) = w; } }
        __syncthreads();
    }
}

constexpr int HB_LD = 2056;
__device__ __forceinline__ void phase_ln_router(const Frame& F, const Args& a, int layer) {
    LAS bf16_t* hb = (LAS bf16_t*)F.lds;
    LAS float* part = (LAS float*)F.lds;
    LAS int* histw = (LAS int*)(F.lds + 141312);
    bf16_t* X = (bf16_t*)(F.ws + WS_X); bf16_t* A0 = (bf16_t*)(F.ws + WS_A0);
    int* SE = (int*)(F.ws + WS_SELE); float* SW = (float*)(F.ws + WS_SELW); int* HIST = (int*)(F.ws + WS_HIST);
    const int tok0 = layer ? TC : 0, TPB = layer ? 32 : 34;
    const float* lng = a.in[I_LNMG] + layer * D; const float* lnb = a.in[I_LNMB] + layer * D;
    const bf16_t* rwh = (const bf16_t*)(F.ws + WS_RWH) + (size_t)layer * NEXP * D; const bf16_t* rwl = (const bf16_t*)(F.ws + WS_RWL) + (size_t)layer * NEXP * D;
    const float rbias = a.in[I_RB][layer * NEXP + F.lane];
    const int fr = F.lane & 15, fq = F.lane >> 4;
    for (int vb = F.bid; vb < 256; vb += F.G) {
        const int rb = tok0 + vb * TPB; int mycnt = 0;
        f32x4 psc[8], psh[8]; int rcur = -1;
        for (int j = F.wave; j < TPB; j += 8) { const int row = rb + j; bf16_t* xr = X + (size_t)row * D;
            f32x4 v[8]; float s = 0.f;
#pragma unroll
            for (int i = 0; i < 8; ++i) { const u32x2 p = *(const GAS u32x2*)(xr + 4 * F.lane + 256 * i); v[i] = (f32x4){bflo(p.x), bfhi(p.x), bflo(p.y), bfhi(p.y)}; s += (v[i][0] + v[i][1]) + (v[i][2] + v[i][3]); }
            const int r = modrow(row);
            if (r != rcur) { rcur = r; const float* sh2 = modp(F.ws, layer, r, 3); const float* sc2 = modp(F.ws, layer, r, 4);
#pragma unroll
                for (int i = 0; i < 8; ++i) { const int c = 4 * F.lane + 256 * i; psc[i] = *(const GAS f32x4*)(sc2 + c) + 1.0f; psh[i] = *(const GAS f32x4*)(sh2 + c); } }
            const float mean = wave_sum(s) * (1.0f / D); float ss = 0.f;
#pragma unroll
            for (int i = 0; i < 8; ++i) { v[i] = v[i] - mean; ss += (v[i][0] * v[i][0] + v[i][1] * v[i][1]) + (v[i][2] * v[i][2] + v[i][3] * v[i][3]); }
            const float rstd = rsqrtf(wave_sum(ss) * (1.0f / D) + LN_EPS);
#pragma unroll
            for (int i = 0; i < 8; ++i) { const int c = 4 * F.lane + 256 * i;
                const f32x4 lat = v[i] * rstd * *(const GAS f32x4*)(lng + c) + *(const GAS f32x4*)(lnb + c);
                { u32x2 wl; wl.x = pk2(lat[0], lat[1]); wl.y = pk2(lat[2], lat[3]); *(GAS u32x2*)(xr + c) = wl; }
                const f32x4 h = lat * psc[i] + psh[i];
                u32x2 w; w.x = pk2(h[0], h[1]); w.y = pk2(h[2], h[3]); *(GAS unsigned*)((unsigned char*)A0 + (size_t)row * D + c) = pk4_fp8(h[0], h[1], h[2], h[3]);
                *(LAS u32x2*)(hb + j * HB_LD + c) = w; } }
        __syncthreads();
        f32x4 acc[3][4];
#pragma unroll
        for (int mt = 0; mt < 3; ++mt)
#pragma unroll
            for (int nt = 0; nt < 4; ++nt) acc[mt][nt] = (f32x4){0.f, 0.f, 0.f, 0.f};
        { int arow[3];
#pragma unroll
          for (int mt = 0; mt < 3; ++mt) { const int rr = 16 * mt + fr; arow[mt] = (rr < TPB ? rr : TPB - 1) * HB_LD; }
#pragma unroll 2
          for (int kk = 0; kk < 8; ++kk) { const int k0 = F.wave * 256 + 32 * kk + 8 * fq;
              bf16x8 bh[4], bl[4], af[3];
#pragma unroll
              for (int nt = 0; nt < 4; ++nt) { bh[nt] = *(const GAS bf16x8*)(rwh + (size_t)(16 * nt + fr) * D + k0); bl[nt] = *(const GAS bf16x8*)(rwl + (size_t)(16 * nt + fr) * D + k0); }
#pragma unroll
              for (int mt = 0; mt < 3; ++mt) af[mt] = *(const LAS bf16x8*)(hb + arow[mt] + k0);
#pragma unroll
              for (int mt = 0; mt < 3; ++mt)
#pragma unroll
                  for (int nt = 0; nt < 4; ++nt) { acc[mt][nt] = __builtin_amdgcn_mfma_f32_16x16x32_bf16(af[mt], bh[nt], acc[mt][nt], 0, 0, 0);
                      acc[mt][nt] = __builtin_amdgcn_mfma_f32_16x16x32_bf16(af[mt], bl[nt], acc[mt][nt], 0, 0, 0); } } }
        __syncthreads();
#pragma unroll
        for (int mt = 0; mt < 3; ++mt)
#pragma unroll
            for (int nt = 0; nt < 4; ++nt)
#pragma unroll
                for (int j = 0; j < 4; ++j) part[(F.wave * 48 + 16 * mt + 4 * fq + j) * 64 + 16 * nt + fr] = acc[mt][nt][j];
        __syncthreads();
        for (int j = F.wave; j < TPB; j += 8) { const int row = rb + j; float logit = 0.f;
#pragma unroll
            for (int w = 0; w < 8; ++w) logit += part[(w * 48 + j) * 64 + F.lane];
            const float sg = 1.0f / (1.0f + expf(-logit)), bsd = sg + rbias;
            float m1 = bsd;
#pragma unroll
            for (int o = 1; o < 8; o <<= 1) m1 = fmaxf(m1, __shfl_xor(m1, o));
            int idx = (bsd == m1) ? (F.lane & 7) : 8;
#pragma unroll
            for (int o = 1; o < 8; o <<= 1) idx = min(idx, __shfl_xor(idx, o));
            float m2 = ((F.lane & 7) == idx) ? -INFINITY : bsd;
#pragma unroll
            for (int o = 1; o < 8; o <<= 1) m2 = fmaxf(m2, __shfl_xor(m2, o));
            const float gs = m1 + m2; const int mygrp = F.lane >> 3; int grank = 0;
#pragma unroll
            for (int gg = 0; gg < 8; ++gg) { const float og = __builtin_bit_cast(float, __builtin_amdgcn_readlane(__builtin_bit_cast(int, gs), gg * 8)); grank += (og > gs || (og == gs && gg < mygrp)) ? 1 : 0; }
            const bool gsel = grank < 4; const float cand = gsel ? bsd : -INFINITY; int rank = 0;
#pragma unroll 8
            for (int e2 = 0; e2 < 64; ++e2) { const float ov = __builtin_bit_cast(float, __builtin_amdgcn_readlane(__builtin_bit_cast(int, cand), e2)); rank += (ov > cand || (ov == cand && e2 < F.lane)) ? 1 : 0; }
            const bool sel = gsel && rank < TOPK;
            const float wsum = wave_sum(sel ? sg : 0.f);
            if (sel) { SE[row * 8 + rank] = F.lane; SW[row * 8 + rank] = sg / wsum * 2.5f; mycnt += 1; } }
        histw[F.wave * 64 + F.lane] = mycnt;
        __syncthreads();
        if (F.tid < 64) { int s = 0;
#pragma unroll
            for (int w = 0; w < 8; ++w) s += histw[w * 64 + F.tid];
            HIST[vb * 64 + F.tid] = s; }
        __syncthreads();
    }
}

__device__ __forceinline__ void phase_scatter(const Frame& F, int layer) {
    LAS int* pall = (LAS int*)F.lds;
    LAS int* plo = pall + 512;
    LAS int* st_l = plo + 512;
    LAS int* sel_l = st_l + 64;
    LAS int* misc = sel_l + 288;
    const int* HIST = (const int*)(F.ws + WS_HIST); const int* SE = (const int*)(F.ws + WS_SELE);
    int* EXPT = (int*)(F.ws + WS_EXPT); int* SLOT_TOK = (int*)(F.ws + WS_SLOTTOK); int* TOK_SLOT = (int*)(F.ws + WS_TOKSLOT);
    const int tok0 = layer ? TC : 0, TPB = layer ? 32 : 34, ntok = T0 - tok0;
    for (int vb = F.bid; vb < 256; vb += F.G) {
        int all = 0, lo = 0;
        for (int b = F.wave * 32; b < F.wave * 32 + 32; ++b) { const int h = HIST[b * 64 + F.lane]; all += h; lo += (b < vb) ? h : 0; }
        pall[F.wave * 64 + F.lane] = all; plo[F.wave * 64 + F.lane] = lo;
        const int rb = tok0 + vb * TPB;
        for (int i = F.tid; i < TPB * 8; i += NTHREADS) sel_l[i] = SE[rb * 8 + i];
        __syncthreads();
        if (F.wave == 0) { int tot = 0, base = 0;
#pragma unroll
            for (int w = 0; w < 8; ++w) { tot += pall[w * 64 + F.lane]; base += plo[w * 64 + F.lane]; }
            const int padded = (tot + 255) & ~255; int incl = padded;
#pragma unroll
            for (int o = 1; o < 64; o <<= 1) { const int t = __shfl_up(incl, o); if (F.lane >= o) incl += t; }
            const int start = incl - padded, total_pad = __shfl(incl, 63);
            st_l[F.lane] = start + base; if (F.lane == 0) misc[0] = total_pad;
            if (vb == 0) { EXPT[F.lane] = start; EXPT[128 + F.lane] = tot; if (F.lane == 0) { EXPT[64] = total_pad; EXPT[128 + 64] = ntok; }
                for (int s = tot; s < padded; ++s) SLOT_TOK[start + s] = tok0; } }
        __syncthreads();
        if (F.tid < TPB * 8) { const int e = sel_l[F.tid]; int rank = 0;
            for (int p = 0; p < F.tid; ++p) rank += (sel_l[p] == e) ? 1 : 0;
            const int slot = st_l[e] + rank, t = rb + (F.tid >> 3);
            SLOT_TOK[slot] = t; TOK_SLOT[t * 8 + (F.tid & 7)] = slot; }
        if (F.tid < TPB) SLOT_TOK[misc[0] + (rb - tok0) + F.tid] = rb + F.tid;
        __syncthreads();
    }
}

__device__ __forceinline__ void phase_combine(const Frame& F, const Args& a, int layer) {
    bf16_t* X = (bf16_t*)(F.ws + WS_X); bf16_t* A0 = (bf16_t*)(F.ws + WS_A0); const unsigned char* YS = F.ws + WS_YS;
    const int* TOK_SLOT = (const int*)(F.ws + WS_TOKSLOT); const float* SW = (const float*)(F.ws + WS_SELW); const int* EXPT = (const int*)(F.ws + WS_EXPT);
    const int tok0 = layer ? TC : 0, TPB = layer ? 32 : 34; const int start64 = EXPT[64];
    LAS float* P = (LAS float*)F.lds;
    for (int i = F.tid; i < 11 * (D / 4); i += NTHREADS) { const int t = i / (D / 4), c = 4 * (i % (D / 4)); f32x4 v;
        if (t == 0) v = *(const GAS f32x4*)(a.in[I_LNFG] + layer * D + c);
        else if (t == 1) v = *(const GAS f32x4*)(a.in[I_LNFB] + layer * D + c);
        else { const int r = (t - 2) / 3, k = (t - 2) % 3;
            if (k == 0) v = *(const GAS f32x4*)(modp(F.ws, layer, r, 5) + c);
            else if (layer == 0) { v = *(const GAS f32x4*)(modp(F.ws, 1, r, k == 1 ? 1 : 0) + c); if (k == 1) v = v + 1.0f; }
            else v = (f32x4){0.f, 0.f, 0.f, 0.f}; }
        *(LAS f32x4*)(P + t * D + c) = v; }
    __syncthreads();
    for (int vb = F.bid; vb < 256; vb += F.G) {
        for (int j = F.wave; j < TPB; j += 8) { const int row = tok0 + vb * TPB + j;
            f32x4 f[8];
            { const unsigned char* ys = YS + (size_t)(start64 + row - tok0) * D;
#pragma unroll
              for (int i = 0; i < 8; ++i) f[i] = up4_fp8(*(const GAS unsigned*)(ys + 4 * F.lane + 256 * i)) * 0.0625f; }
#pragma unroll 2
            for (int jj = 0; jj < 8; ++jj) { const int slot = TOK_SLOT[row * 8 + jj]; const float w = SW[row * 8 + jj] * 0.0625f; const unsigned char* ys = YS + (size_t)slot * D;
#pragma unroll
                for (int i = 0; i < 8; ++i) f[i] += up4_fp8(*(const GAS unsigned*)(ys + 4 * F.lane + 256 * i)) * w; }
            const int r = modrow(row); bf16_t* xr = X + (size_t)row * D; float s = 0.f;
            const LAS float* pg2 = P + (2 + 3 * r) * D;
#pragma unroll
            for (int i = 0; i < 8; ++i) { const int c = 4 * F.lane + 256 * i; const u32x2 p = *(const GAS u32x2*)(xr + c); const f32x4 xv = {bflo(p.x), bfhi(p.x), bflo(p.y), bfhi(p.y)};
                f[i] = xv * ALPHA + *(const LAS f32x4*)(pg2 + c) * f[i]; s += (f[i][0] + f[i][1]) + (f[i][2] + f[i][3]); }
            const float mean = wave_sum(s) * (1.0f / D); float ss = 0.f;
#pragma unroll
            for (int i = 0; i < 8; ++i) { f[i] = f[i] - mean; ss += (f[i][0] * f[i][0] + f[i][1] * f[i][1]) + (f[i][2] * f[i][2] + f[i][3] * f[i][3]); }
            const float rstd = rsqrtf(wave_sum(ss) * (1.0f / D) + LN_EPS);
            if (layer == 0) { const LAS float* psc = P + (3 + 3 * r) * D; const LAS float* psh = P + (4 + 3 * r) * D;
#pragma unroll
                for (int i = 0; i < 8; ++i) { const int c = 4 * F.lane + 256 * i;
                    const f32x4 lat = f[i] * rstd * *(const LAS f32x4*)(P + c) + *(const LAS f32x4*)(P + D + c);
                    { u32x2 wl; wl.x = pk2(lat[0], lat[1]); wl.y = pk2(lat[2], lat[3]); *(GAS u32x2*)(xr + c) = wl; }
                    const f32x4 h = lat * *(const LAS f32x4*)(psc + c) + *(const LAS f32x4*)(psh + c);
                    u32x2 w; w.x = pk2(h[0], h[1]); w.y = pk2(h[2], h[3]); *(GAS u32x2*)(A0 + (size_t)row * D + c) = w; } }
            else { float* o = a.out + (size_t)(row - TC) * D;
#pragma unroll
                for (int i = 0; i < 8; ++i) { const int c = 4 * F.lane + 256 * i; *(GAS f32x4*)(o + c) = f[i] * rstd * *(const LAS f32x4*)(P + c) + *(const LAS f32x4*)(P + D + c); } }
        }
    }
}

__device__ __forceinline__ void phase_attention(const Frame& F, const Args& a) {
    constexpr int ABUF = 35840;
    const bf16_t* QK = (const bf16_t*)(F.ws + WS_Z); const bf16_t* VT = (const bf16_t*)(F.ws + WS_YTL); bf16_t* O = (bf16_t*)(F.ws + WS_MIX);
    const int fr = F.lane & 15, fq = F.lane >> 4;
    const int key0 = F.tid >> 4, c16 = F.tid & 15, dim0 = F.tid >> 3, c8 = F.tid & 7;
    for (int unit = ((F.G % 8 == 0) ? (F.bid % 8) * (F.G / 8) + F.bid / 8 : F.bid); unit < 256; unit += F.G) {
        const int b = unit >> 7, h = (unit >> 5) & 3, n = unit & 31;
        const int kt_lo = (2 * n - 2) < 0 ? 0 : (2 * n - 2), kt_hi = (2 * n + 3) > 63 ? 63 : (2 * n + 3), nband = kt_hi - kt_lo + 1, ntile = nband + 4, nstep = 2 * ntile;
        u32x4 kreg[2], vreg[2];
        const bf16_t* kbase = QK + 2048 + h * 128 + 8 * c16; const bf16_t* vbase = VT + (size_t)(h * 128 + dim0) * T0 + 8 * c8;
#define ATT_LOAD(step_) do { const int ti_ = (step_) % ntile; const bool cx_ = ti_ >= nband; const int kt_ = cx_ ? (ti_ - nband) : (kt_lo + ti_); const int kr_ = cx_ ? (b * CTXL + 64 * kt_) : (TC + b * SEQ + 64 * kt_); \
            kreg[0] = *(const GAS u32x4*)(kbase + (size_t)(kr_ + key0) * 2560); kreg[1] = *(const GAS u32x4*)(kbase + (size_t)(kr_ + key0 + 32) * 2560); \
            vreg[0] = *(const GAS u32x4*)(vbase + kr_); vreg[1] = *(const GAS u32x4*)(vbase + (size_t)64 * T0 + kr_); } while (0)
#define ATT_STORE(buf_) do { LAS bf16_t* Ks_ = (LAS bf16_t*)(F.lds + (buf_) * ABUF); LAS bf16_t* Vs_ = (LAS bf16_t*)(F.lds + (buf_) * ABUF + 17408); \
            *(LAS u32x4*)(Ks_ + key0 * 136 + 8 * c16) = kreg[0]; *(LAS u32x4*)(Ks_ + (key0 + 32) * 136 + 8 * c16) = kreg[1]; \
            *(LAS u32x4*)(Vs_ + dim0 * 72 + 8 * c8) = vreg[0]; *(LAS u32x4*)(Vs_ + (dim0 + 64) * 72 + 8 * c8) = vreg[1]; } while (0)
        __syncthreads();
        ATT_LOAD(0); ATT_STORE(0);
        __syncthreads();
        bf16x8 aq[2][4]; float mrun[2], lrun[2]; f32x4 o[2][8]; int qh = 0, qpos0 = 0, qrow = 0;
        for (int step = 0; step < nstep; ++step) {
            const int ti = step % ntile, pass = step / ntile;
            if (step + 1 < nstep) ATT_LOAD(step + 1);
            if (ti == 0) {
                qh = h * 4 + 2 * pass + (F.wave >> 2); const int rows0 = (F.wave & 3) * 32; qpos0 = n * 128 + rows0; qrow = TC + b * SEQ + qpos0;
#pragma unroll
                for (int m = 0; m < 2; ++m)
#pragma unroll
                    for (int kk = 0; kk < 4; ++kk) aq[m][kk] = *(const GAS bf16x8*)(QK + (size_t)(qrow + 16 * m + fr) * 2560 + qh * 128 + 32 * kk + 8 * fq);
                const float sink = a.in[I_SINK][qh];
                mrun[0] = sink; mrun[1] = sink; lrun[0] = 1.f; lrun[1] = 1.f;
#pragma unroll
                for (int m = 0; m < 2; ++m)
#pragma unroll
                    for (int nd = 0; nd < 8; ++nd) o[m][nd] = (f32x4){0.f, 0.f, 0.f, 0.f};
            }
            const bool isctx = ti >= nband; const int kt = isctx ? (ti - nband) : (kt_lo + ti);
            const LAS bf16_t* Ks = (const LAS bf16_t*)(F.lds + (step & 1) * ABUF); const LAS bf16_t* Vs = (const LAS bf16_t*)(F.lds + (step & 1) * ABUF + 17408);
            f32x4 s[2][4];
#pragma unroll
            for (int m = 0; m < 2; ++m)
#pragma unroll
                for (int nn = 0; nn < 4; ++nn) s[m][nn] = (f32x4){0.f, 0.f, 0.f, 0.f};
#pragma unroll
            for (int kk = 0; kk < 4; ++kk)
#pragma unroll
                for (int nn = 0; nn < 4; ++nn) { const bf16x8 kf = *(const LAS bf16x8*)(Ks + (16 * nn + fr) * 136 + 32 * kk + 8 * fq);
#pragma unroll
                    for (int m = 0; m < 2; ++m) s[m][nn] = __builtin_amdgcn_mfma_f32_16x16x32_bf16(kf, aq[m][kk], s[m][nn], 0, 0, 0); }
            bf16x8 pf[2][2];
#pragma unroll
            for (int m = 0; m < 2; ++m) {
                if (!isctx) { const int qpos = qpos0 + 16 * m + fr;
#pragma unroll
                    for (int nn = 0; nn < 4; ++nn)
#pragma unroll
                        for (int j = 0; j < 4; ++j) { const int d = 64 * kt + 16 * nn + 4 * fq + j - qpos; if (d > 128 || d < -128) s[m][nn][j] = -INFINITY; } }
                float mx = s[m][0][0];
#pragma unroll
                for (int nn = 0; nn < 4; ++nn)
#pragma unroll
                    for (int j = 0; j < 4; ++j) mx = fmaxf(mx, s[m][nn][j]);
                mx = fmaxf(mx, __shfl_xor(mx, 16)); mx = fmaxf(mx, __shfl_xor(mx, 32));
                const float mnew = fmaxf(mrun[m], mx), alpha = __expf(mrun[m] - mnew); mrun[m] = mnew;
                float rs = 0.f;
#pragma unroll
                for (int nn = 0; nn < 4; ++nn)
#pragma unroll
                    for (int j = 0; j < 4; ++j) { const float p = __expf(s[m][nn][j] - mnew); s[m][nn][j] = p; rs += p; }
                rs += __shfl_xor(rs, 16); rs += __shfl_xor(rs, 32);
                lrun[m] = lrun[m] * alpha + rs;
#pragma unroll
                for (int nd = 0; nd < 8; ++nd) o[m][nd] = o[m][nd] * alpha;
#pragma unroll
                for (int ks = 0; ks < 2; ++ks) { u32x4 w; w.x = cvt_pk_bf16(s[m][2 * ks][0], s[m][2 * ks][1]); w.y = cvt_pk_bf16(s[m][2 * ks][2], s[m][2 * ks][3]);
                    w.z = cvt_pk_bf16(s[m][2 * ks + 1][0], s[m][2 * ks + 1][1]); w.w = cvt_pk_bf16(s[m][2 * ks + 1][2], s[m][2 * ks + 1][3]); pf[m][ks] = __builtin_bit_cast(bf16x8, w); }
            }
#pragma unroll
            for (int ks = 0; ks < 2; ++ks)
#pragma unroll
                for (int nd = 0; nd < 8; ++nd) { const LAS bf16_t* vp = Vs + (16 * nd + fr) * 72 + 32 * ks + 4 * fq;
                    u32x4 w; const u32x2 lo = *(const LAS u32x2*)vp, hi = *(const LAS u32x2*)(vp + 16); w.x = lo.x; w.y = lo.y; w.z = hi.x; w.w = hi.y;
                    const bf16x8 vf = __builtin_bit_cast(bf16x8, w);
#pragma unroll
                    for (int m = 0; m < 2; ++m) o[m][nd] = __builtin_amdgcn_mfma_f32_16x16x32_bf16(vf, pf[m][ks], o[m][nd], 0, 0, 0); }
            if (ti == ntile - 1) {
#pragma unroll
                for (int m = 0; m < 2; ++m) { const float inv = 1.0f / lrun[m]; bf16_t* op = O + (size_t)(qrow + 16 * m + fr) * D + qh * 128 + 4 * fq;
#pragma unroll
                    for (int nd = 0; nd < 8; ++nd) { const f32x4 v = o[m][nd] * inv; u32x2 w; w.x = cvt_pk_bf16(v[0], v[1]); w.y = cvt_pk_bf16(v[2], v[3]); *(GAS u32x2*)(op + 16 * nd) = w; } }
            }
            if (step + 1 < nstep) ATT_STORE((step + 1) & 1);
            __syncthreads();
        }
#undef ATT_LOAD
#undef ATT_STORE
    }
}

constexpr int NPHASE = 20;
__global__ void __launch_bounds__(NTHREADS, 2) mk_fwd(Args args) {
    extern __shared__ __attribute__((aligned(16))) unsigned char lds_raw[];
    Frame F; F.lds = (LAS unsigned char*)lds_raw; F.tid = threadIdx.x; F.lane = F.tid & 63; F.wave = __builtin_amdgcn_readfirstlane(F.tid >> 6); F.G = gridDim.x; F.bid = blockIdx.x; F.ws = args.ws;
    volatile LAS unsigned* MISC = (volatile LAS unsigned*)(F.lds + MISC_OFF + 1024);
    if (F.tid < 16) MISC[F.tid] = 0u;
    __syncthreads();
    unsigned* ctl = (unsigned*)(args.ws + WS_CTL);
    XcdBarrier bar; bar.bar = ctl + CW_BAR; bar.x = 0; bar.st = nullptr;
    if (!MK_PER_PHASE) bar = xcd_barrier_post(ctl + CW_BAR, MISC + 8);
    const int lo = args.ph_lo, hi = args.ph_hi;
    unsigned char* ws = args.ws;
#ifndef DUP_PHASE
#define DUP_PHASE -1
#endif
#define IN(k) (lo <= (k) && (k) < hi)
#define REP(k) for (int rep_ = 0; rep_ < ((k) == DUP_PHASE ? 2 : 1); ++rep_)
#define SEAM(k) do { if (IN(k) && IN((k) + 1)) xcd_barrier(bar); } while (0)
    LAS unsigned char* ring = F.lds;
    LAS i32x4* ut = (LAS i32x4*)(F.lds + MISC_OFF + 1152);
    constexpr int QD = 8, QD2 = 11, QG = 3, QM = 1, QS = 4;
    const int vcu = (F.G % 8 == 0) ? (F.bid % 8) * (F.G / 8) + F.bid / 8 : F.bid;

    if (IN(0)) REP(0) { conv_range(F, args, 0, cv::N3 + cv::HALFM); conv_range(F, args, cv::NG, cv::NG + cv::HALFM);
        __syncthreads(); p0_mod(F, args); p0_tables(F, args.in[I_RW]); }
    SEAM(0);
    if (IN(1)) REP(1) phase_modulate0(F, args);
    SEAM(1);
    if (IN(2)) REP(2) { DenseSched S{(const char*)(ws + WS_A0), (const char*)(ws + WS_WIN), D, D, 34, 12, F.G, F.bid}; EpiWin E{(bf16_t*)(ws + WS_Z)};
        pg8::gemm_phase<EpiWin, DenseSched>(ring, D, D, S, E); if (F.bid >= 408 - F.G) conv_pull(F, args, QD2); }
    SEAM(2);
    if (IN(3)) REP(3) { Dft1Sched S{ws, F.G, F.bid}; EpiBf16G E{(bf16_t*)(ws + WS_YTL), (bf16_t*)(ws + WS_YTC), SEQ, CTXL, 1.0f, 1.0f};
        pg8::gemm_phase<EpiBf16G, Dft1Sched>(ring, 256, 3072, S, E); __syncthreads(); phase_sgu(F, args); if (F.bid >= 2 * (272 - F.G)) conv_pull(F, args, QS); }
    SEAM(3);
    if (IN(4)) REP(4) phase_butterfly(F);
    SEAM(4);
    if (IN(5)) REP(5) { Dft2Sched S{ws, F.G, F.bid}; EpiBf16G E{(bf16_t*)(ws + WS_MIX), (bf16_t*)(ws + WS_MIX), D, D, 1.0f / 1024.0f, 1.0f / 256.0f};
        pg8::gemm_phase<EpiBf16G, Dft2Sched>(ring, 512, 512, S, E); if (F.bid >= 136) conv_pull(F, args, QS); }
    SEAM(5);
    if (IN(6)) REP(6) { const int g6 = (F.G == 256) ? 136 : F.G;
        DenseSched S{(const char*)(ws + WS_MIX), (const char*)(ws + WS_WOUT), D, D, 34, 8, g6, F.bid}; EpiResid E{(bf16_t*)(ws + WS_X), args.in[I_X], args.in[I_CTX], ws, 0, 0};
        pg8::gemm_phase<EpiResid, DenseSched>(ring, D, D, S, E);
        if (F.bid >= g6) conv_pull(F, args, 26); else if (F.G != 256 && F.bid >= 272 - F.G) conv_pull(F, args, QD); }
    SEAM(6);
    if (IN(7)) REP(7) phase_ln_router(F, args, 0);
    SEAM(7);
    if (IN(8)) REP(8) { phase_scatter(F, 0); conv_cleanup(F, args, cv::HALFM); }
    SEAM(8);
    if (IN(9)) REP(9) { moe_tables(F, 4, F.G, true); MoeSched S{ws, ut, (const int*)(ws + WS_SLOTTOK), 0}; EpiGateUp E{(bf16_t*)(ws + WS_ACT)};
        pg8::gemm_phase<EpiGateUp, MoeSched, true, true, 122>(ring, D / 2, D / 2, S, E); if (moe_conv(F)) conv_pull(F, args, 34); else if (moe_short(F)) conv_pull(F, args, QG); }
    SEAM(9);
    if (IN(10)) REP(10) { moe_tables(F, 8, F.G, true); MoeDownSched S{ws, ut, 0}; EpiYs8 E{ws + WS_YS};
        pg8::gemm_phase<EpiYs8, MoeDownSched, true, true, 122>(ring, EDIM / 2, EDIM / 2, S, E); if (moe_conv(F)) conv_pull(F, args, 24); else if (moe_short(F)) conv_pull(F, args, QM); }
    SEAM(10);
    if (IN(11)) REP(11) phase_combine(F, args, 0);
    SEAM(11);
    if (IN(12)) REP(12) { QkvSched S{ws, F.G, F.bid}; EpiQkv E{(bf16_t*)(ws + WS_Z), (bf16_t*)(ws + WS_YTL), (const f32x2*)(ws + WS_ROPE)};
        pg8::gemm_phase<EpiQkv, QkvSched>(ring, D, D, S, E); if (F.bid >= 392 - F.G) conv_pull(F, args, QD2); }
    SEAM(12);
    if (IN(13)) REP(13) phase_attention(F, args);
    SEAM(13);
    if (IN(14)) REP(14) { DenseSched S{(const char*)(ws + WS_MIX) + (size_t)TC * D * 2, (const char*)(ws + WS_WAO), D, D, 32, 8, F.G, F.bid}; EpiResid E{(bf16_t*)(ws + WS_X), nullptr, nullptr, ws, 1, TC};
        pg8::gemm_phase<EpiResid, DenseSched>(ring, D, D, S, E); }
    SEAM(14);
    if (IN(15)) REP(15) phase_ln_router(F, args, 1);
    SEAM(15);
    if (IN(16)) REP(16) { phase_scatter(F, 1); conv_cleanup(F, args, 4 * cv::HALFM); }
    SEAM(16);
    if (IN(17)) REP(17) { moe_tables(F, 4, F.G, false); MoeSched S{ws, ut, (const int*)(ws + WS_SLOTTOK), 1}; EpiGateUp E{(bf16_t*)(ws + WS_ACT)};
        pg8::gemm_phase<EpiGateUp, MoeSched, true, true, 122>(ring, D / 2, D / 2, S, E); }
    SEAM(17);
    if (IN(18)) REP(18) { moe_tables(F, 8, F.G, false); MoeDownSched S{ws, ut, 1}; EpiYs8 E{ws + WS_YS};
        pg8::gemm_phase<EpiYs8, MoeDownSched, true, true, 122>(ring, EDIM / 2, EDIM / 2, S, E); }
    SEAM(18);
    if (IN(19)) REP(19) phase_combine(F, args, 1);
#undef IN
#undef SEAM
}

extern "C" void kernel_launch(void* const* d_in, const int* in_sizes, int n_in, void* d_out, int out_size, void* d_ws, size_t ws_size, hipStream_t stream) {
    static int grid = 0;
    if (grid == 0) {
        if (n_in != 27 || out_size != TL * D || ws_size < WS_END) { fprintf(stderr, "kernel_launch: unexpected shapes (n_in %d out %d ws %zu)\n", n_in, out_size, ws_size); grid = -1; return; }
        int dev = 0, cus = 0, per_cu = 0;
        if (hipGetDevice(&dev) != hipSuccess || hipDeviceGetAttribute(&cus, hipDeviceAttributeMultiprocessorCount, dev) != hipSuccess) { grid = -1; return; }
        if (hipFuncSetAttribute((const void*)mk_fwd, hipFuncAttributeMaxDynamicSharedMemorySize, LDS_BYTES) != hipSuccess) { fprintf(stderr, "kernel_launch: hipFuncSetAttribute failed\n"); grid = -1; return; }
        if (hipOccupancyMaxActiveBlocksPerMultiprocessor(&per_cu, (const void*)mk_fwd, NTHREADS, LDS_BYTES) != hipSuccess || per_cu < 1) fprintf(stderr, "kernel_launch: occupancy query reports %d\n", per_cu);
        (void)hipGetLastError();
        grid = cus < 256 ? cus : 256;
    }
    if (grid < 0) return;
    (void)hipMemsetAsync((char*)d_ws + WS_CTL, 0, CTL_ZERO_BYTES, stream);
    Args a{};
    for (int i = 0; i < 27; ++i) a.in[i] = (const float*)d_in[i];
    a.out = (float*)d_out; a.ws = (unsigned char*)d_ws;
#if MK_PER_PHASE
    for (int p = 0; p < NPHASE; ++p) { a.ph_lo = p; a.ph_hi = p + 1; hipLaunchKernelGGL(mk_fwd, dim3(grid), dim3(NTHREADS), LDS_BYTES, stream, a); }
#else
    a.ph_lo = 0; a.ph_hi = NPHASE; hipLaunchKernelGGL(mk_fwd, dim3(grid), dim3(NTHREADS), LDS_BYTES, stream, a);
#endif
}
```

```cpp
#include <hip/hip_runtime.h>
#include <cstdio>
#include <cstdint>

#ifndef MK_PER_PHASE
#define MK_PER_PHASE 0
#endif

#define GAS __attribute__((address_space(1)))
#define LAS __attribute__((address_space(3)))
typedef unsigned short bf16_t;
typedef short bf16x8 __attribute__((ext_vector_type(8)));
typedef float f32x4 __attribute__((ext_vector_type(4)));
typedef float f32x2 __attribute__((ext_vector_type(2)));
typedef unsigned u32x4 __attribute__((ext_vector_type(4)));
typedef unsigned u32x2 __attribute__((ext_vector_type(2)));

constexpr int D = 2048, SEQ = 4096, CTXL = 256, NBATCH = 2;
constexpr int TC = NBATCH * CTXL;
constexpr int TL = NBATCH * SEQ;
constexpr int T0 = TC + TL;
constexpr int NEXP = 64, EDIM = 512, TOPK = 8;
constexpr int NE1 = NEXP + 1;
constexpr int SLOTS = 98304;
constexpr float ALPHA = 1.4142135623730951f;
constexpr float LN_EPS = 1e-6f;
constexpr float QSCALE = 0.08838834764831845f;

constexpr size_t MiB = 1u << 20;
constexpr size_t WS_CTL = 0, CTL_ZERO_BYTES = 32 * 1024;
constexpr size_t WS_MOD = 1 * MiB;
constexpr size_t WS_ROPE = 1 * MiB + 512 * 1024;
constexpr size_t WS_WCT = 2 * MiB;
constexpr size_t WS_T256 = 2 * MiB + 256 * 1024;
constexpr size_t WS_RWH = 2 * MiB + 512 * 1024;
constexpr size_t WS_SELE = 3 * MiB;
constexpr size_t WS_SELW = 3 * MiB + 512 * 1024;
constexpr size_t WS_HIST = 4 * MiB;
constexpr size_t WS_EXPT = 4 * MiB + 128 * 1024;
constexpr size_t WS_SLOTTOK = 4 * MiB + 256 * 1024;
constexpr size_t WS_TOKSLOT = 5 * MiB;
constexpr size_t WS_RWL = 6 * MiB;
constexpr size_t WS_WIN = 8 * MiB;
constexpr size_t WS_WOUT = 20 * MiB;
constexpr size_t WS_WQK = 28 * MiB;
constexpr size_t WS_WV = 38 * MiB;
constexpr size_t WS_WAO = 40 * MiB;
constexpr size_t WS_WGU = 48 * MiB;
constexpr size_t WGU_E = (size_t)1024 * 2048 * 2, WGU_L = 65 * WGU_E;
constexpr size_t WS_WD = WS_WGU + 2 * WGU_L;
constexpr size_t WD_E = (size_t)2048 * 512 * 2, WD_L = 65 * WD_E;
constexpr size_t WGU8_E = (size_t)1024 * 2048, WGU8_L = 65 * WGU8_E;
constexpr size_t WD8_E = (size_t)2048 * 512, WD8_L = 65 * WD8_E;
constexpr size_t WS_X = 832 * MiB;
constexpr size_t WS_A0 = 900 * MiB;
constexpr size_t WS_Z = 934 * MiB;
constexpr size_t WS_YTL = 985 * MiB;
constexpr size_t WS_YTC = 1017 * MiB;
constexpr size_t WS_GT = 1019 * MiB;
constexpr size_t WS_MIX = 1051 * MiB;
constexpr size_t WS_ACT = 1085 * MiB;
constexpr size_t WS_YS = 1181 * MiB;
constexpr size_t WS_END = 1565 * MiB;
static_assert(WS_WD + 2 * WD_L <= WS_X && WS_YS + (size_t)SLOTS * 2048 * 2 <= WS_END, "ws map");
constexpr int CW_BAR = 4096;
static_assert((CW_BAR + 3456) * 4 <= (int)CTL_ZERO_BYTES, "barrier words inside the per-call memset");

constexpr int RING_BYTES = 131072;
constexpr int MISC_OFF = 145408;
constexpr int LDS_BYTES = 147456;
constexpr int NWAVES = 8, NTHREADS = 512;

#define LDS_WAIT() asm volatile("s_waitcnt lgkmcnt(0)" ::: "memory")
#define VM_WAIT() asm volatile("s_waitcnt vmcnt(0)" ::: "memory")
__device__ __forceinline__ unsigned f2bf(float f) { unsigned u = __builtin_bit_cast(unsigned, f); return (u + 0x7fffu + ((u >> 16) & 1u)) >> 16; }
__device__ __forceinline__ unsigned pk2(float lo, float hi) { return f2bf(lo) | (f2bf(hi) << 16); }
__device__ __forceinline__ float bf2f(unsigned short b) { return __builtin_bit_cast(float, ((unsigned)b) << 16); }
__device__ __forceinline__ float bflo(unsigned w) { return __builtin_bit_cast(float, w << 16); }
__device__ __forceinline__ float bfhi(unsigned w) { return __builtin_bit_cast(float, w & 0xffff0000u); }
__device__ __forceinline__ float wave_sum(float v) {
#pragma unroll
    for (int o = 1; o < 64; o <<= 1) v += __shfl_xor(v, o);
    return v;
}
__device__ __forceinline__ float gelu_tanh(float x) { const float u = 0.7978845608028654f * (x + 0.044715f * x * x * x); return x * __builtin_amdgcn_rcpf(1.0f + __expf(-2.0f * u)); }
__device__ __forceinline__ float sat8(float x) { return __builtin_amdgcn_fmed3f(x, -448.0f, 448.0f); }
__device__ __forceinline__ unsigned pk4_fp8(float a, float b, float c, float d) { int w = 0; w = __builtin_amdgcn_cvt_pk_fp8_f32(sat8(a), sat8(b), w, false); w = __builtin_amdgcn_cvt_pk_fp8_f32(sat8(c), sat8(d), w, true); return (unsigned)w; }
__device__ __forceinline__ f32x4 up4_fp8(unsigned w) { const f32x2 lo = __builtin_amdgcn_cvt_pk_f32_fp8((int)w, false), hi = __builtin_amdgcn_cvt_pk_f32_fp8((int)w, true); return (f32x4){lo[0], lo[1], hi[0], hi[1]}; }
__device__ __forceinline__ float silu_f(float x) { return x * __builtin_amdgcn_rcpf(1.0f + __expf(-x)); }

#define XB_TMO      128
#define XB_XCNT(j)  (256  + 64 * (j))
#define XB_XSUB(j)  (1280 + 64 * (j))
#define XB_XGEN(j)  (2304 + 64 * (j))
#define XB_TOP      3328
#define XB_TOPGEN   3392
#define XCD_BAR_WORDS 3456
#define XB_SPIN_CAP (1u << 18)
__device__ __forceinline__ unsigned xb_ld(unsigned* p)              { return __hip_atomic_load(p, __ATOMIC_RELAXED, __HIP_MEMORY_SCOPE_AGENT); }
__device__ __forceinline__ unsigned xb_add(unsigned* p, unsigned v) { return __hip_atomic_fetch_add(p, v, __ATOMIC_RELAXED, __HIP_MEMORY_SCOPE_AGENT); }
__device__ __forceinline__ unsigned xb_xcc_id() { return (unsigned)__builtin_amdgcn_s_getreg((3 << 11) | 20) & 0xFu; }
#define XB_SPIN(cond, bar) do { unsigned _sp = 0; while (cond) { __builtin_amdgcn_s_sleep(1); \
    if ((++_sp & 255u) == 0u) { if (xb_ld(&(bar)[XB_TMO])) break; if (_sp > XB_SPIN_CAP) { atomicAdd(&(bar)[XB_TMO], 1u); break; } } } } while (0)
struct XcdBarrier { unsigned* bar; unsigned x; volatile LAS unsigned* st; };
__device__ __forceinline__ XcdBarrier xcd_barrier_post(unsigned* bar, volatile LAS unsigned* st) {
    XcdBarrier b; b.bar = bar; b.x = xb_xcc_id(); b.st = st;
    if (threadIdx.x == 0) (void)xb_add(&bar[XB_XCNT(b.x)], 1u);
    return b;
}
__device__ __forceinline__ void xcd_barrier_complete(unsigned* bar, unsigned x, unsigned& nloc, unsigned& nx) {
    const unsigned G = gridDim.x * gridDim.y * gridDim.z;
    unsigned sum, cnt, mine, sp = 0u;
    for (;;) {
        sum = 0u; cnt = 0u; mine = 0u;
#pragma unroll
        for (unsigned j = 0; j < 16; ++j) { const unsigned c = xb_ld(&bar[XB_XCNT(j)]); sum += c; cnt += (c > 0u) ? 1u : 0u; mine = (j == x) ? c : mine; }
        if (sum == G) break;
        __builtin_amdgcn_s_sleep(1);
        if ((++sp & 255u) == 0u) { if (xb_ld(&bar[XB_TMO])) break; if (sp > XB_SPIN_CAP) { atomicAdd(&bar[XB_TMO], 1u); break; } }
    }
    nloc = mine > 0u ? mine : 1u; nx = cnt > 0u ? cnt : 1u;
}
__device__ __forceinline__ void xcd_barrier(const XcdBarrier& b) {
    asm volatile("s_waitcnt vmcnt(0)" ::: "memory");
    __syncthreads();
    if (threadIdx.x == 0) {
        unsigned* bar = b.bar;
        __builtin_amdgcn_s_waitcnt(0);
        unsigned nloc = b.st[0], nx = b.st[1];
        if (nloc == 0u) { xcd_barrier_complete(bar, b.x, nloc, nx); b.st[0] = nloc; b.st[1] = nx; }
        const unsigned old = xb_add(&bar[XB_XSUB(b.x)], 1u);
        const unsigned gen = old / nloc;
        if (old + 1u == (gen + 1u) * nloc) {
            __builtin_amdgcn_fence(__ATOMIC_RELEASE, "agent");
            asm volatile("s_waitcnt vmcnt(0)" ::: "memory");
            const unsigned og = xb_add(&bar[XB_TOP], 1u);
            const unsigned tg = og / nx;
            if (og + 1u == (tg + 1u) * nx) xb_add(&bar[XB_TOPGEN], 1u);
            else XB_SPIN(xb_ld(&bar[XB_TOPGEN]) == tg, bar);
            __builtin_amdgcn_fence(__ATOMIC_ACQUIRE, "agent");
            xb_add(&bar[XB_XGEN(b.x)], 1u);
            asm volatile("s_waitcnt vmcnt(0)" ::: "memory");
        } else {
            XB_SPIN(xb_ld(&bar[XB_XGEN(b.x)]) == gen, bar);
            __builtin_amdgcn_fence(__ATOMIC_ACQUIRE, "agent");
            asm volatile("s_waitcnt vmcnt(0)" ::: "memory");
        }
    }
    __syncthreads();
}

namespace pg8 {
constexpr int BM = 256, BK = 64, HALF = 128, HTB = HALF * BK * 2, NXCD = 8, WGM = 8;
__host__ __device__ __forceinline__ int lds_byte(int r, int c) { const int st = (r >> 4) * 2 + (c >> 5), rr = r & 15, cc = c & 31, ob = rr * 64 + cc * 2; return st * 1024 + (ob ^ (((ob >> 9) & 1) << 5)); }
__host__ __device__ __forceinline__ void stage_rc(int b, int& R, int& C) { const int st = b / 1024, sb = b % 1024, swz = sb ^ (((sb >> 9) & 1) << 5); R = (st >> 1) * 16 + swz / 64; C = (st & 1) * 32 + (swz % 64) / 2; }
__host__ __device__ __forceinline__ int perm32(int rho) { const int n = rho >> 4, i = rho & 15; return 8 * (i >> 2) + 4 * n + (i & 3); }
__device__ __forceinline__ unsigned cvt_pk_bf16(float lo, float hi) { unsigned r; asm volatile("v_cvt_pk_bf16_f32 %0, %1, %2" : "=v"(r) : "v"(lo), "v"(hi)); return r; }

struct Unit { const char* a; const char* b; int i0, i1, i2, i3; };

__device__ __forceinline__ void tile_order(int L, int nM, int nN, int& pm, int& pn) {
    const int nwg = nM * nN; int wgid = L;
    { const int q = nwg / NXCD, r = nwg % NXCD, xcd = wgid % NXCD, off = wgid / NXCD; wgid = (xcd < r ? xcd * (q + 1) : r * (q + 1) + (xcd - r) * q) + off; }
    const int nig = WGM * nN, gid = wgid / nig, fm = gid * WGM, gsz = (nM - fm) < WGM ? (nM - fm) : WGM;
    pm = fm + ((wgid % nig) % gsz); pn = (wgid % nig) / gsz;
}

typedef int i32x4m __attribute__((ext_vector_type(4)));
typedef int i32x8m __attribute__((ext_vector_type(8)));
__device__ __forceinline__ i32x8m cat8(bf16x8 a, bf16x8 b) { return __builtin_shufflevector(__builtin_bit_cast(i32x4m, a), __builtin_bit_cast(i32x4m, b), 0, 1, 2, 3, 4, 5, 6, 7); }
template <class Epi, class Sched, bool ALIGN_EPI = true, bool F8 = false, int SCALE_B = 127>
__device__ __forceinline__ void gemm_phase(LAS unsigned char* lds, const int K, const int ldb, const Sched& S, const Epi& E) {
    const int tid = threadIdx.x, wid = __builtin_amdgcn_readfirstlane(tid >> 6), lane = tid & 63, wr = wid >> 2, wc = wid & 3, fr = lane & 15, fq = lane >> 4;
    const int nt = K / BK;
    int sR[2], sC[2]; unsigned voffB[2];
#pragma unroll
    for (int i = 0; i < 2; ++i) { stage_rc(tid * 16 + i * 8192, sR[i], sC[i]); int Rb = Epi::PERM ? ((sR[i] & ~31) + perm32(sR[i] & 31)) : sR[i];
        if constexpr ((int)Epi::PERM == 2) Rb = 64 * (sR[i] >> 5) + 16 * ((sR[i] >> 2) & 3) + 4 * ((sR[i] >> 4) & 1) + (sR[i] & 3);
        voffB[i] = (unsigned)(Rb * ldb + sC[i]) * 2u; }
    const size_t kstep = (size_t)(BK * 2);
    const size_t hstepB = (size_t)((int)Epi::PERM == 2 ? 8 : HALF) * ldb * 2;
    const unsigned ldsw = (unsigned)wid * 1024u;
    const int aoff = lds_byte(wr * 64 + fr, fq * 8), boff = lds_byte(wc * 32 + fr, fq * 8);
#define PG8_SA(b, h) (((b) * 2 + (h)) * HTB)
#define PG8_SB(b, h) ((4 + (b) * 2 + (h)) * HTB)
#define PG8_STAGE2(bufoff, gbase, v0, v1) do { \
        __builtin_amdgcn_global_load_lds((const unsigned*)((const char*)(gbase) + (v0)), (LAS unsigned*)(lds + (bufoff) + ldsw), 16, 0, 0); \
        __builtin_amdgcn_global_load_lds((const unsigned*)((const char*)(gbase) + (v1)), (LAS unsigned*)(lds + (bufoff) + ldsw + 8192), 16, 0, 0); } while (0)
#define PG8_STAGEB(bufoff, gbase) PG8_STAGE2(bufoff, gbase, voffB[0], voffB[1])
#define PG8_LDA(dst, b, h) do { _Pragma("unroll") for (int m = 0; m < 4; ++m) { if constexpr (F8) dst##8[m] = cat8(*(const LAS bf16x8*)(lds + PG8_SA(b, h) + aoff + m * 2048), *(const LAS bf16x8*)(lds + PG8_SA(b, h) + aoff + m * 2048 + 1024)); \
        else { _Pragma("unroll") for (int k = 0; k < 2; ++k) dst[m][k] = *(const LAS bf16x8*)(lds + PG8_SA(b, h) + aoff + m * 2048 + k * 1024); } } } while (0)
#define PG8_LDB(dst, b, h) do { _Pragma("unroll") for (int n = 0; n < 2; ++n) { if constexpr (F8) dst##8[n] = cat8(*(const LAS bf16x8*)(lds + PG8_SB(b, h) + boff + n * 2048), *(const LAS bf16x8*)(lds + PG8_SB(b, h) + boff + n * 2048 + 1024)); \
        else { _Pragma("unroll") for (int k = 0; k < 2; ++k) dst[n][k] = *(const LAS bf16x8*)(lds + PG8_SB(b, h) + boff + n * 2048 + k * 1024); } } } while (0)
#define PG8_MMA(ai, bj, At, Bt) do { __builtin_amdgcn_s_setprio(1); _Pragma("unroll") for (int m = 0; m < 4; ++m) _Pragma("unroll") for (int n = 0; n < 2; ++n) { \
        if constexpr (F8) asm volatile("v_mfma_scale_f32_16x16x128_f8f6f4 %0, %1, %2, %0, %3, %4 op_sel_hi:[0,0,0]" : "+v"(acc[ai][bj][m][n]) : "v"(Bt##8[n]), "v"(At##8[m]), "v"(scb), "v"(sca)); \
        else { _Pragma("unroll") for (int k = 0; k < 2; ++k) acc[ai][bj][m][n] = __builtin_amdgcn_mfma_f32_16x16x32_bf16(Bt[n][k], At[m][k], acc[ai][bj][m][n], 0, 0, 0); } } \
        __builtin_amdgcn_s_setprio(0); } while (0)
#define PG8_WAIT_V(n) asm volatile("s_waitcnt vmcnt(" #n ")" ::: "memory")
#define PG8_WAIT_L(n) asm volatile("s_waitcnt lgkmcnt(" #n ")" ::: "memory")
#define PG8_BAR __builtin_amdgcn_s_barrier()
#define PG8_SCHED __builtin_amdgcn_sched_barrier(0)
    Unit cur, nxt; int ui = 0;
    if (!S.next(0, cur)) return;
    f32x4 acc[2][2][4][2];
#pragma unroll
    for (int a = 0; a < 2; ++a)
#pragma unroll
        for (int b = 0; b < 2; ++b)
#pragma unroll
            for (int m = 0; m < 4; ++m)
#pragma unroll
                for (int n = 0; n < 2; ++n) acc[a][b][m][n] = (f32x4){0.f, 0.f, 0.f, 0.f};
    int scb = SCALE_B, sca = 127; asm volatile("" : "+v"(scb), "+v"(sca));
    bf16x8 At[4][2], B0[2][2], B1[2][2]; i32x8m At8[4], B08[2], B18[2];
    unsigned cv00 = S.aoff(cur, sR[0], sC[0]), cv01 = S.aoff(cur, sR[1], sC[1]), cv10 = S.aoff(cur, HALF + sR[0], sC[0]), cv11 = S.aoff(cur, HALF + sR[1], sC[1]);
    const char* cA = cur.a; const char* cB = cur.b;
    PG8_STAGEB(PG8_SB(0, 0), cB); PG8_STAGEB(PG8_SB(0, 1), cB + hstepB); PG8_STAGE2(PG8_SA(0, 0), cA, cv00, cv01); PG8_STAGE2(PG8_SA(0, 1), cA, cv10, cv11);
    if (wr == 1) PG8_BAR;
    PG8_WAIT_V(2); PG8_BAR;
    PG8_STAGEB(PG8_SB(1, 0), cB + kstep); PG8_STAGE2(PG8_SA(1, 0), cA + kstep, cv00, cv01); PG8_STAGEB(PG8_SB(1, 1), cB + hstepB + kstep);
    PG8_WAIT_V(6); PG8_BAR;
    for (;;) {
        const bool has_next = S.next(ui + 1, nxt);
        const char* nA = has_next ? nxt.a : cA; const char* nB = has_next ? nxt.b : cB;
        unsigned nv00 = cv00, nv01 = cv01, nv10 = cv10, nv11 = cv11;
        if (Sched::GATHER && has_next && nt < 6) { nv00 = S.aoff(nxt, sR[0], sC[0]); nv01 = S.aoff(nxt, sR[1], sC[1]); nv10 = S.aoff(nxt, HALF + sR[0], sC[0]); nv11 = S.aoff(nxt, HALF + sR[1], sC[1]); }
#pragma nounroll
        for (int t = 0; t < nt; t += 2) {
            const bool last = (t == nt - 2);
            const char* a1 = cA + (size_t)(t + 1) * kstep;
            const char* a2 = last ? nA : cA + (size_t)(t + 2) * kstep; const char* b2 = last ? nB : cB + (size_t)(t + 2) * kstep;
            const char* a3 = a2 + kstep; const char* b3 = b2 + kstep;
            const unsigned x00 = last ? nv00 : cv00, x01 = last ? nv01 : cv01, x10 = last ? nv10 : cv10, x11 = last ? nv11 : cv11;
            PG8_LDB(B0, 0, 0); PG8_LDB(B1, 0, 1); PG8_SCHED; PG8_LDA(At, 0, 0); PG8_STAGE2(PG8_SA(1, 1), a1, cv10, cv11);
            PG8_WAIT_V(8); PG8_WAIT_L(0); PG8_BAR; PG8_MMA(0, 0, At, B0); PG8_MMA(0, 1, At, B1); PG8_BAR; PG8_SCHED;
            PG8_LDA(At, 0, 1); PG8_STAGEB(PG8_SB(0, 0), b2); PG8_STAGEB(PG8_SB(0, 1), b2 + hstepB); PG8_STAGE2(PG8_SA(0, 0), a2, x00, x01);
            PG8_WAIT_V(8); PG8_WAIT_L(0); PG8_BAR; PG8_MMA(1, 0, At, B0); PG8_MMA(1, 1, At, B1); PG8_BAR; PG8_SCHED;
            PG8_LDB(B0, 1, 0); PG8_LDB(B1, 1, 1); PG8_SCHED; PG8_LDA(At, 1, 0); PG8_STAGE2(PG8_SA(0, 1), a2, x10, x11);
            PG8_WAIT_V(8); PG8_WAIT_L(0); PG8_BAR; PG8_MMA(0, 0, At, B0); PG8_MMA(0, 1, At, B1); PG8_BAR; PG8_SCHED;
            PG8_LDA(At, 1, 1); PG8_STAGEB(PG8_SB(1, 0), b3); PG8_STAGEB(PG8_SB(1, 1), b3 + hstepB); PG8_STAGE2(PG8_SA(1, 0), a3, x00, x01);
            PG8_WAIT_V(8); PG8_WAIT_L(0); PG8_BAR; PG8_MMA(1, 0, At, B0); PG8_MMA(1, 1, At, B1); PG8_BAR; PG8_SCHED;
            if (Sched::GATHER && has_next && nt >= 6 && t == nt - 6) { nv00 = S.aoff(nxt, sR[0], sC[0]); nv01 = S.aoff(nxt, sR[1], sC[1]); nv10 = S.aoff(nxt, HALF + sR[0], sC[0]); nv11 = S.aoff(nxt, HALF + sR[1], sC[1]); }
        }
        if constexpr (ALIGN_EPI) { if (wr == 0) PG8_BAR; }
        if constexpr (F8) asm volatile("s_nop 15\n\ts_nop 3" ::: "memory");
        E(acc, cur, wr, wc, fr, fq);
        if (!has_next) break;
#pragma unroll
        for (int a = 0; a < 2; ++a)
#pragma unroll
            for (int b = 0; b < 2; ++b)
#pragma unroll
                for (int m = 0; m < 4; ++m)
#pragma unroll
                    for (int n = 0; n < 2; ++n) acc[a][b][m][n] = (f32x4){0.f, 0.f, 0.f, 0.f};
        cur = nxt; cA = nA; cB = nB; cv00 = nv00; cv01 = nv01; cv10 = nv10; cv11 = nv11; ++ui;
        if constexpr (ALIGN_EPI) { if (wr == 1) PG8_BAR; }
    }
    PG8_WAIT_V(0);
    if constexpr (!ALIGN_EPI) { if (wr == 0) PG8_BAR; }
    PG8_BAR;
#undef PG8_SA
#undef PG8_SB
#undef PG8_STAGE2
#undef PG8_STAGEB
#undef PG8_LDA
#undef PG8_LDB
#undef PG8_MMA
#undef PG8_WAIT_V
#undef PG8_WAIT_L
#undef PG8_BAR
#undef PG8_SCHED
}
}
using pg8::Unit;
using pg8::cvt_pk_bf16;

struct Args { const float* in[27]; float* out; unsigned char* ws; int ph_lo, ph_hi; };
enum { I_X = 0, I_C, I_CTX, I_CCTX, I_ADAW, I_ADAB, I_LNMG, I_LNMB, I_LNFG, I_LNFB, I_WIN, I_SLNG, I_SLNB, I_SWS, I_SBS, I_WOUT, I_WQKV, I_SINK, I_WAO,
       I_RW, I_RB, I_MG, I_MU, I_MD, I_SG, I_SU, I_SD };

struct Frame {
    LAS unsigned char* lds;
    int tid, lane, wave, G, bid;
    unsigned char* ws;
};
__device__ __forceinline__ int modrow(int row) { return row < TC ? 2 : ((row - TC) >> 12); }
__device__ __forceinline__ const float* modp(const unsigned char* ws, int layer, int r, int chunk) { return (const float*)(ws + WS_MOD) + ((size_t)(layer * 3 + r) * 6 + chunk) * D; }

struct ConvJob { const float* src; bf16_t* dst; int K, N, mode; };
__device__ __forceinline__ int rope_pos(int d) { const int half = d >> 6, which = (d >> 5) & 1, f = d & 31; return 32 * (half * 2 + (f >> 4)) + 8 * ((f & 15) >> 2) + 4 * which + (f & 3); }
__device__ __forceinline__ void conv_item8(const float* __restrict__ src, int K, int N, int k0, int n0, unsigned char* dst, int mode, LAS float* scr, int lane) {
    f32x4 ld[16];
#pragma unroll
    for (int i = 0; i < 16; ++i) { const int kr = 8 * i + (lane >> 3), c4 = lane & 7; ld[i] = __builtin_nontemporal_load((const GAS f32x4*)(src + (size_t)(k0 + kr) * N + n0 + 4 * c4)); }
#pragma unroll
    for (int i = 0; i < 16; ++i) { const int kr = 8 * i + (lane >> 3), c4 = lane & 7;
        LAS float* s = scr + kr * 33 + 4 * c4; s[0] = ld[i][0]; s[1] = ld[i][1]; s[2] = ld[i][2]; s[3] = ld[i][3]; }
    LDS_WAIT(); asm volatile("" ::: "memory");
    const int c = lane & 15;
#pragma unroll
    for (int j = 0; j < 8; ++j) { const int nl = 4 * j + (lane >> 4), n = n0 + nl; const LAS float* s = scr + (8 * c) * 33 + nl;
        u32x2 o; o.x = pk4_fp8(32.f * s[0], 32.f * s[33], 32.f * s[2 * 33], 32.f * s[3 * 33]); o.y = pk4_fp8(32.f * s[4 * 33], 32.f * s[5 * 33], 32.f * s[6 * 33], 32.f * s[7 * 33]);
        const int row = mode == 0 ? n : (n >> 7) * 256 + (mode == 3 ? 128 : 0) + (n & 127);
        *(GAS u32x2*)(dst + (size_t)row * K + k0 + 8 * c) = o; }
    LDS_WAIT(); asm volatile("" ::: "memory");
}
__device__ __forceinline__ void conv_item(const float* __restrict__ src, int K, int N, int k0, int n0, bf16_t* dst, int mode, bf16_t* dst_v, LAS float* scr, int lane, bool f8 = false) {
    f32x4 ld[16];
#pragma unroll
    for (int i = 0; i < 16; ++i) { const int kr = 4 * i + (lane >> 4), c4 = lane & 15; ld[i] = __builtin_nontemporal_load((const GAS f32x4*)(src + (size_t)(k0 + kr) * N + n0 + 4 * c4)); }
#pragma unroll
    for (int i = 0; i < 16; ++i) { const int kr = 4 * i + (lane >> 4), c4 = lane & 15;
        LAS float* s = scr + kr * 65 + 4 * c4; s[0] = ld[i][0]; s[1] = ld[i][1]; s[2] = ld[i][2]; s[3] = ld[i][3]; }
    LDS_WAIT(); asm volatile("" ::: "memory");
    const int c = lane & 7;
#pragma unroll
    for (int j = 0; j < 8; ++j) { const int nl = 8 * j + (lane >> 3), n = n0 + nl; const LAS float* s = scr + (8 * c) * 65 + nl;
        if (f8) {
            u32x2 o; o.x = pk4_fp8(32.f * s[0], 32.f * s[65], 32.f * s[2 * 65], 32.f * s[3 * 65]); o.y = pk4_fp8(32.f * s[4 * 65], 32.f * s[5 * 65], 32.f * s[6 * 65], 32.f * s[7 * 65]);
            const int row = mode == 0 ? n : (n >> 7) * 256 + (mode == 3 ? 128 : 0) + (n & 127);
            *(GAS u32x2*)((unsigned char*)dst + (size_t)row * K + k0 + 8 * c) = o; continue; }
        u32x4 o; o.x = pk2(s[0], s[65]); o.y = pk2(s[2 * 65], s[3 * 65]); o.z = pk2(s[4 * 65], s[5 * 65]); o.w = pk2(s[6 * 65], s[7 * 65]);
        bf16_t* drow;
        if (mode == 0) drow = dst + (size_t)n * K;
        else if (mode == 1) { if (n < 2560) drow = dst + (size_t)((n & ~127) + rope_pos(n & 127)) * K; else drow = dst_v + (size_t)(n - 2560) * K; }
        else { const int ntile = n >> 7, r = n & 127; drow = dst + (size_t)(ntile * 256 + (mode == 3 ? 128 : 0) + r) * K; }
        *(GAS u32x4*)(drow + k0 + 8 * c) = o; }
    LDS_WAIT(); asm volatile("" ::: "memory");
}
namespace cv { constexpr int I_A = 32 * 48, I_B = 32 * 32, I_E = 256; constexpr int N0 = I_A, N1 = N0 + I_B, N2 = N1 + I_A, N3 = N2 + I_B, NG = N3 + 130 * I_E, NU = NG + 130 * I_E, ND = NU + 130 * I_E, HALFM = 65 * I_E; }
constexpr int CW_QHEAD = 2048;
static __device__ __forceinline__ void conv_impl(LAS unsigned char* lds, unsigned char* ws, const float* win, const float* wout, const float* wqkv, const float* wao, const float* mg, const float* mu, const float* md,
                                       const float* sg, const float* su, const float* sd, int it_lo, int it_hi, int gw, int NGW, unsigned* qhead, int quota) {
    using namespace cv;
    const int lane = threadIdx.x & 63, wave = threadIdx.x >> 6;
    LAS float* scr = (LAS float*)(lds + wave * 16896);
    int it0 = it_lo + gw; bool deferred = false;
    if (qhead) { deferred = true;
        if (quota >= 0) { unsigned d = 0u; if (lane == 0) d = __hip_atomic_fetch_add(qhead, (unsigned)quota, __ATOMIC_RELAXED, __HIP_MEMORY_SCOPE_AGENT);
            it0 = __builtin_amdgcn_readfirstlane((int)d); it_hi = it0 + quota; NGW = 1; }
        else { const unsigned h = __hip_atomic_load(qhead, __ATOMIC_RELAXED, __HIP_MEMORY_SCOPE_AGENT); it0 = (int)h + gw; }
        if (it_hi > 4 * HALFM) it_hi = 4 * HALFM; }
    for (;;) {
        if (it0 >= it_hi) break;
        int it = it0; it0 += NGW;
        if (deferred) it = it < HALFM ? NU + it : it < 2 * HALFM ? N3 + it : it < 3 * HALFM ? NG + it - HALFM : NU + it - 2 * HALFM;
        const float* src; bf16_t* dst; bf16_t* dstv = nullptr; int K, N, mode, r; bool f8 = false;
        if (it < N0) { r = it; src = win; dst = (bf16_t*)(ws + WS_WIN); K = 2048; N = 3072; mode = 0; }
        else if (it < N1) { r = it - N0; src = wout; dst = (bf16_t*)(ws + WS_WOUT); K = 2048; N = 2048; mode = 0; }
        else if (it < N2) { r = it - N1; src = wqkv; dst = (bf16_t*)(ws + WS_WQK); dstv = (bf16_t*)(ws + WS_WV); K = 2048; N = 3072; mode = 1; }
        else if (it < N3) { r = it - N2; src = wao; dst = (bf16_t*)(ws + WS_WAO); K = 2048; N = 2048; mode = 0; }
        else {
            int cls, q; if (it < NG) { cls = 0; q = it - N3; } else if (it < NU) { cls = 1; q = it - NG; } else { cls = 2; q = it - NU; }
            const int mat = q / I_E; r = q % I_E; const int layer = mat / 65, e = mat % 65;
            if (cls < 2) { K = 2048; N = 512; mode = 2 + cls;
                src = (e < 64) ? (cls == 0 ? mg : mu) + ((size_t)(layer * 64 + e)) * 2048 * 512 : (cls == 0 ? sg : su) + (size_t)layer * 2048 * 512;
                dst = (bf16_t*)(ws + WS_WGU + layer * WGU8_L + e * WGU8_E); f8 = true; }
            else { K = 512; N = 2048; mode = 0;
                src = (e < 64) ? md + ((size_t)(layer * 64 + e)) * 512 * 2048 : sd + (size_t)layer * 512 * 2048;
                dst = (bf16_t*)(ws + WS_WD + layer * WD8_L + e * WD8_E); f8 = true; }
        }
        if (f8) { const int nb = N / 32, kb = r / nb, nbi = r % nb; conv_item8(src, K, N, kb * 128, nbi * 32, (unsigned char*)dst, mode, scr, lane); }
        else { const int nb = N / 64, kb = r / nb, nbi = r % nb; conv_item(src, K, N, kb * 64, nbi * 64, dst, mode, dstv, scr, lane, false); }
    }
}
__device__ __forceinline__ void conv_range(const Frame& F, const Args& a, int it_lo, int it_hi) {
    conv_impl(F.lds, F.ws, a.in[I_WIN], a.in[I_WOUT], a.in[I_WQKV], a.in[I_WAO], a.in[I_MG], a.in[I_MU], a.in[I_MD], a.in[I_SG], a.in[I_SU], a.in[I_SD], it_lo, it_hi, F.bid * NWAVES + F.wave, F.G * NWAVES, nullptr, 0);
}
__device__ __forceinline__ void conv_pull(const Frame& F, const Args& a, int quota) {
    if (quota > 0) conv_impl(F.lds, F.ws, a.in[I_WIN], a.in[I_WOUT], a.in[I_WQKV], a.in[I_WAO], a.in[I_MG], a.in[I_MU], a.in[I_MD], a.in[I_SG], a.in[I_SU], a.in[I_SD], 0, 0, 0, 1, (unsigned*)(F.ws + WS_CTL) + CW_QHEAD, quota);
}
__device__ __forceinline__ void conv_cleanup(const Frame& F, const Args& a, int upto) {
    conv_impl(F.lds, F.ws, a.in[I_WIN], a.in[I_WOUT], a.in[I_WQKV], a.in[I_WAO], a.in[I_MG], a.in[I_MU], a.in[I_MD], a.in[I_SG], a.in[I_SU], a.in[I_SD], 0, upto, F.bid * NWAVES + F.wave, F.G * NWAVES, (unsigned*)(F.ws + WS_CTL) + CW_QHEAD, -1);
}
__device__ __forceinline__ void p0_mod(const Frame& F, const Args& a) {
    LAS float* sv = (LAS float*)F.lds;
    LAS float* red = (LAS float*)(F.lds + 32768);
    for (int i = F.tid; i < 3 * D; i += NTHREADS) { const int r = i / D, k = i % D; const float v = r < 2 ? a.in[I_C][r * D + k] : a.in[I_CCTX][k]; sv[i] = silu_f(v); }
    __syncthreads();
    float* mod = (float*)(F.ws + WS_MOD);
    for (int u = F.bid; u < 256; u += F.G) {
        const int layer = u >> 7, n0 = (u & 127) * 96;
        const float* W = a.in[I_ADAW] + (size_t)layer * D * 12288;
        const int kq = F.lane / 24, c4 = F.lane % 24; const bool act = F.lane < 48;
        f32x4 acc[3] = {{0.f, 0.f, 0.f, 0.f}, {0.f, 0.f, 0.f, 0.f}, {0.f, 0.f, 0.f, 0.f}};
        if (act) {
#pragma unroll 8
            for (int it = 0; it < 128; ++it) { const int k = F.wave * 256 + it * 2 + kq;
                const f32x4 w = __builtin_nontemporal_load((const GAS f32x4*)(W + (size_t)k * 12288 + n0 + 4 * c4));
#pragma unroll
                for (int r = 0; r < 3; ++r) acc[r] += w * sv[r * D + k]; } }
#pragma unroll
        for (int r = 0; r < 3; ++r)
#pragma unroll
            for (int j = 0; j < 4; ++j) { const float o = __shfl(acc[r][j], (F.lane + 24) & 63); if (F.lane < 24) red[(F.wave * 3 + r) * 96 + 4 * c4 + j] = acc[r][j] + o; }
        __syncthreads();
        if (F.tid < 288) { const int r = F.tid / 96, cidx = F.tid % 96; float s = 0.f;
#pragma unroll
            for (int w = 0; w < 8; ++w) s += red[(w * 3 + r) * 96 + cidx];
            mod[(size_t)(layer * 3 + r) * 12288 + n0 + cidx] = s + a.in[I_ADAB][layer * 12288 + n0 + cidx]; }
        __syncthreads();
    }
}
__device__ __forceinline__ void p0_tables(const Frame& F, const float* rwsrc) {
    bf16_t* wct = (bf16_t*)(F.ws + WS_WCT); bf16_t* t256 = (bf16_t*)(F.ws + WS_T256); f32x2* rope = (f32x2*)(F.ws + WS_ROPE);
    const int gt = F.bid * NTHREADS + F.tid, NGT = F.G * NTHREADS;
    for (int i = gt; i < 256 * 256; i += NGT) { const int m = i >> 8, c = i & 255, j = (m * c) & 255;
        const float cs = cospif((float)j * (1.0f / 128.0f)), sn = sinpif((float)j * (1.0f / 128.0f));
        wct[(2 * m) * 256 + c] = (bf16_t)f2bf(cs); wct[(2 * m + 1) * 256 + c] = (bf16_t)f2bf(-sn);
        t256[m * 512 + c] = (bf16_t)f2bf(cs); t256[m * 512 + 256 + c] = (bf16_t)f2bf(sn); }
    for (int i = gt; i < 2 * D * NEXP; i += NGT) { const int layer = i / (D * NEXP), k = (i / NEXP) % D, e = i % NEXP; const float w = rwsrc[i];
        const unsigned hi = f2bf(w); const float lo = w - __builtin_bit_cast(float, hi << 16);
        ((bf16_t*)(F.ws + WS_RWH))[(size_t)(layer * NEXP + e) * D + k] = (bf16_t)hi; ((bf16_t*)(F.ws + WS_RWL))[(size_t)(layer * NEXP + e) * D + k] = (bf16_t)f2bf(lo); }
    for (int i = gt; i < 64 * 32; i += NGT) { const int id = i >> 5, f = i & 31;
        const double inv = pow(10000.0, -(double)f / 32.0); const double ang = (double)id * (double)(float)inv;
        rope[i] = (f32x2){(float)cos(ang), (float)sin(ang)}; }
}

__device__ __forceinline__ void phase_modulate0(const Frame& F, const Args& a) {
    bf16_t* A0 = (bf16_t*)(F.ws + WS_A0);
    const int gw = F.bid * NWAVES + F.wave, NGW = F.G * NWAVES;
    for (int row = gw; row < T0; row += NGW) {
        const float* src = row < TC ? a.in[I_CTX] + (size_t)row * D : a.in[I_X] + (size_t)(row - TC) * D;
        const int r = modrow(row); const float* sh = modp(F.ws, 0, r, 0); const float* sc = modp(F.ws, 0, r, 1);
#pragma unroll
        for (int j = 0; j < 8; ++j) { const int c = 4 * F.lane + 256 * j;
            const f32x4 v = *(const GAS f32x4*)(src + c), s = *(const GAS f32x4*)(sc + c), h = *(const GAS f32x4*)(sh + c);
            const f32x4 o = v * (s + 1.0f) + h; u32x2 w; w.x = pk2(o[0], o[1]); w.y = pk2(o[2], o[3]);
            *(GAS u32x2*)(A0 + (size_t)row * D + c) = w; }
    }
}

__device__ __forceinline__ void phase_butterfly(const Frame& F) {
    LAS f32x2* tw = (LAS f32x2*)F.lds;
    for (int j = F.tid; j < 4096; j += NTHREADS) { const float x = (float)j * (1.0f / 2048.0f); tw[j] = (f32x2){cospif(x), sinpif(x)}; }
    __syncthreads();
    const bf16_t* Yt = (const bf16_t*)(F.ws + WS_YTL); bf16_t* Gt = (bf16_t*)(F.ws + WS_GT);
    for (int item = F.bid * NTHREADS + F.tid; item < 2 * 1024 * 64; item += F.G * NTHREADS) {
        const int lq = item & 63, n = (item >> 6) & 1023, b = item >> 16, l1 = 4 * lq;
        const bf16_t* yre = Yt + ((size_t)(b * 1024 + n) * 2 + 0) * 4096 + l1; const bf16_t* yim = yre + 4096;
        float are[16][4], aim[16][4];
#pragma unroll
        for (int l2 = 0; l2 < 16; ++l2) { const u32x2 p = *(const GAS u32x2*)(yre + 256 * l2), q = *(const GAS u32x2*)(yim + 256 * l2);
            are[l2][0] = bflo(p.x); are[l2][1] = bfhi(p.x); are[l2][2] = bflo(p.y); are[l2][3] = bfhi(p.y);
            aim[l2][0] = bflo(q.x); aim[l2][1] = bfhi(q.x); aim[l2][2] = bflo(q.y); aim[l2][3] = bfhi(q.y); }
        for (int r = 0; r < 16; ++r) {
            float sre[4] = {0.f, 0.f, 0.f, 0.f}, sim[4] = {0.f, 0.f, 0.f, 0.f};
#pragma unroll
            for (int l2 = 0; l2 < 16; ++l2) { const f32x2 cs = tw[((l2 * r) & 15) * 256];
#pragma unroll
                for (int e = 0; e < 4; ++e) { sre[e] += are[l2][e] * cs.x + aim[l2][e] * cs.y; sim[e] += aim[l2][e] * cs.x - are[l2][e] * cs.y; } }
            float gre[4], gim[4];
#pragma unroll
            for (int e = 0; e < 4; ++e) { const f32x2 cs = tw[((l1 + e) * r) & 4095]; gre[e] = sre[e] * cs.x + sim[e] * cs.y; gim[e] = sim[e] * cs.x - sre[e] * cs.y; }
            bf16_t* g = Gt + ((size_t)((b * 16 + r) * 1024 + n) * 2) * 256 + l1;
            u32x2 w; w.x = pk2(gre[0], gre[1]); w.y = pk2(gre[2], gre[3]); *(GAS u32x2*)g = w;
            w.x = pk2(gim[0], gim[1]); w.y = pk2(gim[2], gim[3]); *(GAS u32x2*)(g + 256) = w;
        }
    }
}

struct DenseSched {
    static constexpr bool GATHER = false;
    const char* A; const char* B; int lda, ldb, nM, nN, G, c;
    __device__ __forceinline__ bool next(int i, Unit& u) const { const int L = i * G + c; if (c >= G || L >= nM * nN) return false; int pm, pn; pg8::tile_order(L, nM, nN, pm, pn);
        u.a = A + (size_t)pm * 256 * lda * 2; u.b = B + (size_t)pn * 256 * ldb * 2; u.i0 = pm; u.i1 = pn; u.i2 = 0; u.i3 = 0; return true; }
    __device__ __forceinline__ unsigned aoff(const Unit&, int R, int C) const { return (unsigned)(R * lda + C) * 2u; }
};
struct EpiWin { static constexpr bool PERM = true; bf16_t* Z;
    __device__ __forceinline__ void operator()(const f32x4 (&acc)[2][2][4][2], const Unit& u, int wr, int wc, int fr, int fq) const {
        const int row0 = u.i0 * 256 + wr * 64 + fr, col0 = u.i1 * 256 + wc * 32 + 8 * fq; const bool act = u.i1 >= 4;
#pragma unroll
        for (int ai = 0; ai < 2; ++ai)
#pragma unroll
            for (int m = 0; m < 4; ++m) { bf16_t* rowp = Z + (size_t)(row0 + ai * 128 + m * 16) * 3072 + col0;
#pragma unroll
                for (int bj = 0; bj < 2; ++bj) { f32x4 v0 = acc[ai][bj][m][0], v1 = acc[ai][bj][m][1];
                    if (act) {
#pragma unroll
                        for (int j = 0; j < 4; ++j) { v0[j] = gelu_tanh(v0[j]); v1[j] = gelu_tanh(v1[j]); } }
                    u32x4 w; w.x = cvt_pk_bf16(v0[0], v0[1]); w.y = cvt_pk_bf16(v0[2], v0[3]); w.z = cvt_pk_bf16(v1[0], v1[1]); w.w = cvt_pk_bf16(v1[2], v1[3]);
                    *(GAS u32x4*)(rowp + bj * 128) = w; } }
    }
};
struct EpiResid { static constexpr bool PERM = true; bf16_t* X; const float* rx; const float* rctx; const unsigned char* ws; int layer, rowbase;
    __device__ __forceinline__ void operator()(const f32x4 (&acc)[2][2][4][2], const Unit& u, int wr, int wc, int fr, int fq) const {
        const int row0 = rowbase + u.i0 * 256 + wr * 64 + fr, col0 = u.i1 * 256 + wc * 32 + 8 * fq;
        const float* g1 = modp(ws, layer, modrow(rowbase + u.i0 * 256), 2) + col0;
        f32x4 gv[2][2];
#pragma unroll
        for (int bj = 0; bj < 2; ++bj)
#pragma unroll
            for (int n = 0; n < 2; ++n) gv[bj][n] = *(const GAS f32x4*)(g1 + bj * 128 + n * 4);
#pragma unroll
        for (int ai = 0; ai < 2; ++ai)
#pragma unroll
            for (int m = 0; m < 4; ++m) { const int row = row0 + ai * 128 + m * 16; bf16_t* op = X + (size_t)row * D + col0;
#pragma unroll
                for (int bj = 0; bj < 2; ++bj) { f32x4 r0, r1;
                    if (layer == 0) { const float* rp = (row < TC ? rctx + (size_t)row * D : rx + (size_t)(row - TC) * D) + col0 + bj * 128; r0 = *(const GAS f32x4*)rp; r1 = *(const GAS f32x4*)(rp + 4); }
                    else { const u32x4 p = *(const GAS u32x4*)(op + bj * 128); r0 = (f32x4){bflo(p.x), bfhi(p.x), bflo(p.y), bfhi(p.y)}; r1 = (f32x4){bflo(p.z), bfhi(p.z), bflo(p.w), bfhi(p.w)}; }
                    const f32x4 v0 = r0 * ALPHA + gv[bj][0] * acc[ai][bj][m][0], v1 = r1 * ALPHA + gv[bj][1] * acc[ai][bj][m][1];
                    u32x4 w; w.x = cvt_pk_bf16(v0[0], v0[1]); w.y = cvt_pk_bf16(v0[2], v0[3]); w.z = cvt_pk_bf16(v1[0], v1[1]); w.w = cvt_pk_bf16(v1[2], v1[3]);
                    *(GAS u32x4*)(op + bj * 128) = w; } }
    }
};
struct EpiBf16G { static constexpr bool PERM = true; bf16_t* O0; bf16_t* O1; int ldc0, ldc1; float sc0, sc1;
    __device__ __forceinline__ void operator()(const f32x4 (&acc)[2][2][4][2], const Unit& u, int wr, int wc, int fr, int fq) const {
        bf16_t* O = u.i3 ? O1 : O0; const int ldc = u.i3 ? ldc1 : ldc0; const float sc = u.i3 ? sc1 : sc0; const int rs = u.i1;
        const int r0 = wr * 64 + fr, col0 = u.i2 + wc * 32 + 8 * fq;
#pragma unroll
        for (int ai = 0; ai < 2; ++ai)
#pragma unroll
            for (int m = 0; m < 4; ++m) { bf16_t* rowp = O + (size_t)(u.i0 + rs * (r0 + ai * 128 + m * 16)) * ldc + col0;
#pragma unroll
                for (int bj = 0; bj < 2; ++bj) { const f32x4 v0 = acc[ai][bj][m][0] * sc, v1 = acc[ai][bj][m][1] * sc;
                    u32x4 w; w.x = cvt_pk_bf16(v0[0], v0[1]); w.y = cvt_pk_bf16(v0[2], v0[3]); w.z = cvt_pk_bf16(v1[0], v1[1]); w.w = cvt_pk_bf16(v1[2], v1[3]);
                    *(GAS u32x4*)(rowp + bj * 128) = w; } }
    }
};
struct EpiYs8 { static constexpr int PERM = 2; unsigned char* YS;
    __device__ __forceinline__ void operator()(const f32x4 (&acc)[2][2][4][2], const Unit& u, int wr, int wc, int fr, int fq) const {
        const int r0 = wr * 64 + fr, col0 = u.i2 + wc * 64 + 16 * fq;
#pragma unroll
        for (int ai = 0; ai < 2; ++ai)
#pragma unroll
            for (int m = 0; m < 4; ++m) { unsigned char* rowp = YS + (size_t)(u.i0 + r0 + ai * 128 + m * 16) * D + col0;
                const f32x4 v00 = acc[ai][0][m][0] * 16.0f, v01 = acc[ai][0][m][1] * 16.0f, v10 = acc[ai][1][m][0] * 16.0f, v11 = acc[ai][1][m][1] * 16.0f;
                u32x4 w; w.x = pk4_fp8(v00[0], v00[1], v00[2], v00[3]); w.y = pk4_fp8(v01[0], v01[1], v01[2], v01[3]); w.z = pk4_fp8(v10[0], v10[1], v10[2], v10[3]); w.w = pk4_fp8(v11[0], v11[1], v11[2], v11[3]);
                *(GAS u32x4*)rowp = w; }
    }
};
struct Dft1Sched { static constexpr bool GATHER = false; const unsigned char* ws; int G, c;
    __device__ __forceinline__ bool next(int i, Unit& u) const { const int L = i * G + c; if (L >= 272) return false;
        int bg, mt, ntile, isctx; if (L < 256) { bg = L >> 5; mt = (L >> 4) & 1; ntile = L & 15; isctx = 0; } else { const int v = L - 256; bg = v >> 1; mt = v & 1; ntile = 0; isctx = 1; }
        const int b = bg >> 2, g = bg & 3, rowbase = isctx ? b * CTXL : TC + b * SEQ;
        u.a = (const char*)(ws + WS_WCT) + (size_t)mt * 256 * 256 * 2; u.b = (const char*)(ws + WS_Z) + ((size_t)(rowbase + ntile * 256) * 3072 + g * 256) * 2;
        u.i0 = bg * 512 + mt * 256; u.i1 = 1; u.i2 = ntile * 256; u.i3 = isctx; return true; }
    __device__ __forceinline__ unsigned aoff(const Unit&, int R, int C) const { return (unsigned)(R * 256 + C) * 2u; }
};
struct Dft2Sched { static constexpr bool GATHER = false; const unsigned char* ws; int G, c;
    __device__ __forceinline__ bool next(int i, Unit& u) const { const int L = i * G + c; if (L >= 136) return false;
        u.a = (const char*)(ws + WS_T256); u.i2 = (L & 3) * 256;
        if (L < 128) { const int b = L >> 6, r = (L >> 2) & 15, nt = L & 3; u.b = (const char*)(ws + WS_GT) + ((size_t)((b * 16 + r) * 1024 + nt * 256) * 512) * 2; u.i0 = TC + b * SEQ + r; u.i1 = 16; u.i3 = 0; }
        else { const int v = L - 128, b = v >> 2, nt = v & 3; u.b = (const char*)(ws + WS_YTC) + ((size_t)(b * 1024 + nt * 256) * 512) * 2; u.i0 = b * CTXL; u.i1 = 1; u.i3 = 1; }
        return true; }
    __device__ __forceinline__ unsigned aoff(const Unit&, int R, int C) const { return (unsigned)(R * 512 + C) * 2u; }
};
struct QkvSched { static constexpr bool GATHER = false; const unsigned char* ws; int G, c;
    __device__ __forceinline__ bool next(int i, Unit& u) const { const int L = i * G + c; if (L >= 392) return false;
        const char* A0 = (const char*)(ws + WS_A0);
        if (L < 324) { int pm, pn; if (L < 320) { pg8::tile_order(L, 32, 10, pm, pn); pm += 2; } else { pm = (L - 320) >> 1; pn = 8 + ((L - 320) & 1); }
            u.a = A0 + (size_t)pm * 256 * D * 2; u.b = (const char*)(ws + WS_WQK) + (size_t)pn * 256 * D * 2; u.i0 = pm * 256; u.i1 = pn; u.i2 = 0; u.i3 = 0; }
        else { const int v = L - 324, mt = v & 1, ntile = v >> 1;
            u.a = (const char*)(ws + WS_WV) + (size_t)mt * 256 * D * 2; u.b = A0 + (size_t)ntile * 256 * D * 2; u.i0 = mt * 256; u.i1 = ntile; u.i2 = 1; u.i3 = 0; }
        return true; }
    __device__ __forceinline__ unsigned aoff(const Unit&, int R, int C) const { return (unsigned)(R * D + C) * 2u; }
};
struct EpiQkv { static constexpr bool PERM = true; bf16_t* QK; bf16_t* VT; const f32x2* rope;
    __device__ __forceinline__ void operator()(const f32x4 (&acc)[2][2][4][2], const Unit& u, int wr, int wc, int fr, int fq) const {
        const int r0 = u.i0 + wr * 64 + fr;
        if (u.i2) {
            const int col0 = u.i1 * 256 + wc * 32 + 8 * fq;
#pragma unroll
            for (int ai = 0; ai < 2; ++ai)
#pragma unroll
                for (int m = 0; m < 4; ++m) { bf16_t* rowp = VT + (size_t)(r0 + ai * 128 + m * 16) * T0 + col0;
#pragma unroll
                    for (int bj = 0; bj < 2; ++bj) { const f32x4 v0 = acc[ai][bj][m][0], v1 = acc[ai][bj][m][1];
                        u32x4 w; w.x = cvt_pk_bf16(v0[0], v0[1]); w.y = cvt_pk_bf16(v0[2], v0[3]); w.z = cvt_pk_bf16(v1[0], v1[1]); w.w = cvt_pk_bf16(v1[2], v1[3]);
                        *(GAS u32x4*)(rowp + bj * 128) = w; } }
            return; }
        const int col0 = u.i1 * 256 + wc * 32 + 8 * fq; const float qs = u.i1 < 8 ? QSCALE : 1.0f; const bool dorope = u.i0 >= TC;
        const int half = wc >> 1, f0 = (wc & 1) * 16 + fq * 4;
#pragma unroll
        for (int ai = 0; ai < 2; ++ai)
#pragma unroll
            for (int m = 0; m < 4; ++m) { const int row = r0 + ai * 128 + m * 16; bf16_t* rowp = QK + (size_t)row * 2560 + col0;
                f32x4 cs0 = {1.f, 0.f, 1.f, 0.f}, cs1 = {1.f, 0.f, 1.f, 0.f};
                if (dorope) { const int s = (row - TC) & (SEQ - 1), id = half ? (s & 63) : (s >> 6); const GAS f32x4* rp = (const GAS f32x4*)(rope + id * 32 + f0); cs0 = rp[0]; cs1 = rp[1]; }
#pragma unroll
                for (int bj = 0; bj < 2; ++bj) { const f32x4 x1 = acc[ai][bj][m][0], x2 = acc[ai][bj][m][1]; f32x4 o1, o2;
                    o1[0] = x1[0] * cs0[0] - x2[0] * cs0[1]; o2[0] = x2[0] * cs0[0] + x1[0] * cs0[1];
                    o1[1] = x1[1] * cs0[2] - x2[1] * cs0[3]; o2[1] = x2[1] * cs0[2] + x1[1] * cs0[3];
                    o1[2] = x1[2] * cs1[0] - x2[2] * cs1[1]; o2[2] = x2[2] * cs1[0] + x1[2] * cs1[1];
                    o1[3] = x1[3] * cs1[2] - x2[3] * cs1[3]; o2[3] = x2[3] * cs1[2] + x1[3] * cs1[3];
                    o1 = o1 * qs; o2 = o2 * qs;
                    u32x4 w; w.x = cvt_pk_bf16(o1[0], o1[1]); w.y = cvt_pk_bf16(o1[2], o1[3]); w.z = cvt_pk_bf16(o2[0], o2[1]); w.w = cvt_pk_bf16(o2[2], o2[3]);
                    *(GAS u32x4*)(rowp + bj * 128) = w; } }
    }
};
typedef int i32x4 __attribute__((ext_vector_type(4)));
__device__ __forceinline__ void moe_tables(const Frame& F, int NT, int G, bool spare) {
    LAS int* tb = (LAS int*)(F.lds + MISC_OFF);
    LAS i32x4* ut = (LAS i32x4*)(F.lds + MISC_OFF + 1152);
    if (F.tid == 0) { const int* st = (const int*)(F.ws + WS_EXPT); const int* cn = st + 128; int cc = 0;
        for (int e = 0; e < NE1; ++e) { const int t = (cn[e] + 255) >> 8; tb[e] = cc; tb[66 + e] = t; tb[132 + e] = st[e]; cc += t * NT; }
        tb[65] = cc;
        int geff = G, c = (G % 8 == 0) ? (F.bid % 8) * (G / 8) + F.bid / 8 : F.bid, isconv = 0;
        if (spare && G == 256 && cc > 0) { const int rounds = (cc + G - 1) / G; geff = (cc + rounds - 1) / rounds; const int d = G - geff, x = F.bid & 7, li = F.bid >> 3;
            const int dx = d / 8 + (x < d % 8 ? 1 : 0); isconv = li >= 32 - dx; c = x * 32 - (x * (d / 8) + (x < d % 8 ? x : d % 8)) + li; }
        tb[202] = isconv; tb[200] = geff; tb[201] = c; }
    __syncthreads();
    if (F.tid < 32) { const int geff = tb[200], c = tb[201]; const int L = F.tid * geff + c; i32x4 v = {0, 0, 0, 0};
        if (!tb[202] && L < tb[65]) { int e = 0; while (L >= tb[e + 1]) ++e;
            const int rem = L - tb[e], t = tb[66 + e], mt = rem % t, nt = rem / t; v = (i32x4){e, tb[132 + e] + mt * 256, nt, 1}; }
        ut[F.tid] = v; }
    __syncthreads();
}
__device__ __forceinline__ bool moe_short(const Frame& F) { const LAS int* tb = (const LAS int*)(F.lds + MISC_OFF); const int total = tb[65], geff = tb[200], c = tb[201]; const int mx = (total + geff - 1) / geff; const int mine = total > c ? (total - c - 1) / geff + 1 : 0; return !tb[202] && mine < mx; }
__device__ __forceinline__ bool moe_conv(const Frame& F) { return ((const LAS int*)(F.lds + MISC_OFF))[202] != 0; }
struct MoeSched { static constexpr bool GATHER = true;
    const unsigned char* ws; LAS i32x4* ut; const int* slot_tok; int layer;
    __device__ __forceinline__ bool next(int i, Unit& u) const { if (i >= 32) return false; const i32x4 v = ut[i]; if (!v[3]) return false;
        u.a = (const char*)(ws + WS_A0); u.b = (const char*)(ws + WS_WGU) + (size_t)layer * WGU8_L + (size_t)v[0] * WGU8_E + (size_t)v[2] * 256 * D;
        u.i0 = v[1]; u.i1 = v[2]; u.i2 = v[0]; u.i3 = 0; return true; }
    __device__ __forceinline__ unsigned aoff(const Unit& u, int R, int C) const { return (unsigned)(slot_tok[u.i0 + R] * (D / 2) + C) * 2u; }
};
struct EpiGateUp { static constexpr bool PERM = true; bf16_t* ACT;
    __device__ __forceinline__ void operator()(const f32x4 (&acc)[2][2][4][2], const Unit& u, int wr, int wc, int fr, int fq) const {
        const int r0 = u.i0 + wr * 64 + fr, col0 = u.i1 * 128 + wc * 32 + 8 * fq;
#pragma unroll
        for (int ai = 0; ai < 2; ++ai)
#pragma unroll
            for (int m = 0; m < 4; ++m) { f32x4 h0, h1;
#pragma unroll
                for (int j = 0; j < 4; ++j) { h0[j] = silu_f(acc[ai][0][m][0][j]) * acc[ai][1][m][0][j]; h1[j] = silu_f(acc[ai][0][m][1][j]) * acc[ai][1][m][1][j]; }
                u32x2 w; w.x = pk4_fp8(h0[0], h0[1], h0[2], h0[3]); w.y = pk4_fp8(h1[0], h1[1], h1[2], h1[3]);
                *(GAS u32x2*)((unsigned char*)ACT + (size_t)(r0 + ai * 128 + m * 16) * EDIM + col0) = w; }
    }
};
struct MoeDownSched { static constexpr bool GATHER = false; const unsigned char* ws; LAS i32x4* ut; int layer;
    __device__ __forceinline__ bool next(int i, Unit& u) const { if (i >= 32) return false; const i32x4 v = ut[i]; if (!v[3]) return false;
        u.a = (const char*)(ws + WS_ACT) + (size_t)v[1] * EDIM; u.b = (const char*)(ws + WS_WD) + (size_t)layer * WD8_L + (size_t)v[0] * WD8_E + (size_t)v[2] * 256 * EDIM;
        u.i0 = v[1]; u.i1 = 1; u.i2 = v[2] * 256; u.i3 = 0; return true; }
    __device__ __forceinline__ unsigned aoff(const Unit&, int R, int C) const { return (unsigned)(R * (EDIM / 2) + C) * 2u; }
};

__device__ __forceinline__ void phase_sgu(const Frame& F, const Args& a) {
    LAS bf16_t* wA = (LAS bf16_t*)F.lds;
    LAS bf16_t* vT = (LAS bf16_t*)(F.lds + 34816);
    const bf16_t* Z = (const bf16_t*)(F.ws + WS_Z); bf16_t* MIX = (bf16_t*)(F.ws + WS_MIX);
    const int fr = F.lane & 15, fq = F.lane >> 4;
    for (int rnd = 0;; ++rnd) { const int unit = (F.G != 256) ? F.bid + rnd * F.G : rnd == 0 ? F.bid : (rnd == 1 && F.bid >= 16 && F.bid < 32) ? 256 + F.bid - 16 : (1 << 20); if (unit >= 272) break;
        const int chunk = unit >> 2, g = unit & 3, r0 = chunk * 128;
        const float* wsrc = a.in[I_SWS] + (size_t)g * 128 * 128;
#pragma unroll
        for (int i = 0; i < 8; ++i) { const int idx = F.tid + 512 * i, p = idx >> 5, q4 = idx & 31; const f32x4 v = *(const GAS f32x4*)(wsrc + p * 128 + 4 * q4);
            u32x2 w; w.x = pk2(v[0], v[1]); w.y = pk2(v[2], v[3]); *(LAS u32x2*)(wA + p * 136 + 4 * q4) = w; }
        { const int rg = F.tid >> 5, c8 = F.tid & 31; const int cb = g * 256 + 8 * c8;
          const f32x4 lg0 = *(const GAS f32x4*)(a.in[I_SLNG] + cb), lg1 = *(const GAS f32x4*)(a.in[I_SLNG] + cb + 4), lb0 = *(const GAS f32x4*)(a.in[I_SLNB] + cb), lb1 = *(const GAS f32x4*)(a.in[I_SLNB] + cb + 4);
#pragma unroll 2
          for (int pass = 0; pass < 8; ++pass) { const int q = pass * 16 + rg;
            const u32x4 raw = *(const GAS u32x4*)(Z + (size_t)(r0 + q) * 3072 + 2048 + cb);
            float x[8] = {bflo(raw.x), bfhi(raw.x), bflo(raw.y), bfhi(raw.y), bflo(raw.z), bfhi(raw.z), bflo(raw.w), bfhi(raw.w)};
            float s = 0.f;
#pragma unroll
            for (int i = 0; i < 8; ++i) s += x[i];
#pragma unroll
            for (int o = 1; o < 32; o <<= 1) s += __shfl_xor(s, o);
            const float mean = s * (1.0f / 256.0f); float ss = 0.f;
#pragma unroll
            for (int i = 0; i < 8; ++i) { x[i] -= mean; ss += x[i] * x[i]; }
#pragma unroll
            for (int o = 1; o < 32; o <<= 1) ss += __shfl_xor(ss, o);
            const float rstd = rsqrtf(ss * (1.0f / 256.0f) + LN_EPS);
#pragma unroll
            for (int i = 0; i < 8; ++i) { const float gg = i < 4 ? lg0[i & 3] : lg1[i & 3], bb = i < 4 ? lb0[i & 3] : lb1[i & 3];
                vT[(8 * c8 + i) * 136 + (q ^ ((c8 & 15) << 3))] = (bf16_t)f2bf(x[i] * rstd * gg + bb); } } }
        __syncthreads();
        const int pm = F.wave & 1, cn = F.wave >> 1;
        f32x4 acc[4][4];
#pragma unroll
        for (int m = 0; m < 4; ++m)
#pragma unroll
            for (int n = 0; n < 4; ++n) acc[m][n] = (f32x4){0.f, 0.f, 0.f, 0.f};
#pragma unroll
        for (int kk = 0; kk < 4; ++kk) { bf16x8 am[4], bn[4];
#pragma unroll
            for (int m = 0; m < 4; ++m) am[m] = *(const LAS bf16x8*)(wA + (64 * pm + 16 * m + fr) * 136 + 32 * kk + 8 * fq);
#pragma unroll
            for (int n = 0; n < 4; ++n) { const int cr = 64 * cn + 16 * n + fr; bn[n] = *(const LAS bf16x8*)(vT + cr * 136 + ((32 * kk + 8 * fq) ^ (((cr >> 3) & 15) << 3))); }
#pragma unroll
            for (int m = 0; m < 4; ++m)
#pragma unroll
                for (int n = 0; n < 4; ++n) acc[m][n] = __builtin_amdgcn_mfma_f32_16x16x32_bf16(bn[n], am[m], acc[m][n], 0, 0, 0); }
#pragma unroll
        for (int m = 0; m < 4; ++m) { const int p = 64 * pm + 16 * m + fr, row = r0 + p; const float bias = a.in[I_SBS][g * 128 + p];
#pragma unroll
            for (int n = 0; n < 4; ++n) { const int c = g * 256 + 64 * cn + 16 * n + 4 * fq;
                const u32x2 uu = *(const GAS u32x2*)(Z + (size_t)row * 3072 + 1024 + c);
                const float s0 = bflo(uu.x) * (acc[m][n][0] + bias), s1 = bfhi(uu.x) * (acc[m][n][1] + bias), s2 = bflo(uu.y) * (acc[m][n][2] + bias), s3 = bfhi(uu.y) * (acc[m][n][3] + bias);
                u32x2 w; w.x = pk2(s0, s1); w.y = pk2(s2, s3); *(GAS u32x2*)(MIX + (size_t)row * D + 1024 + c) = w; } }
        __syncthreads();
    }
}

constexpr int HB_LD = 2056;
__device__ __forceinline__ void phase_ln_router(const Frame& F, const Args& a, int layer) {
    LAS bf16_t* hb = (LAS bf16_t*)F.lds;
    LAS float* part = (LAS float*)F.lds;
    LAS int* histw = (LAS int*)(F.lds + 141312);
    bf16_t* X = (bf16_t*)(F.ws + WS_X); bf16_t* A0 = (bf16_t*)(F.ws + WS_A0);
    int* SE = (int*)(F.ws + WS_SELE); float* SW = (float*)(F.ws + WS_SELW); int* HIST = (int*)(F.ws + WS_HIST);
    const int tok0 = layer ? TC : 0, TPB = layer ? 32 : 34;
    const float* lng = a.in[I_LNMG] + layer * D; const float* lnb = a.in[I_LNMB] + layer * D;
    const bf16_t* rwh = (const bf16_t*)(F.ws + WS_RWH) + (size_t)layer * NEXP * D; const bf16_t* rwl = (const bf16_t*)(F.ws + WS_RWL) + (size_t)layer * NEXP * D;
    const float rbias = a.in[I_RB][layer * NEXP + F.lane];
    const int fr = F.lane & 15, fq = F.lane >> 4;
    for (int vb = F.bid; vb < 256; vb += F.G) {
        const int rb = tok0 + vb * TPB; int mycnt = 0;
        f32x4 psc[8], psh[8]; int rcur = -1;
        for (int j = F.wave; j < TPB; j += 8) { const int row = rb + j; bf16_t* xr = X + (size_t)row * D;
            f32x4 v[8]; float s = 0.f;
#pragma unroll
            for (int i = 0; i < 8; ++i) { const u32x2 p = *(const GAS u32x2*)(xr + 4 * F.lane + 256 * i); v[i] = (f32x4){bflo(p.x), bfhi(p.x), bflo(p.y), bfhi(p.y)}; s += (v[i][0] + v[i][1]) + (v[i][2] + v[i][3]); }
            const int r = modrow(row);
            if (r != rcur) { rcur = r; const float* sh2 = modp(F.ws, layer, r, 3); const float* sc2 = modp(F.ws, layer, r, 4);
#pragma unroll
                for (int i = 0; i < 8; ++i) { const int c = 4 * F.lane + 256 * i; psc[i] = *(const GAS f32x4*)(sc2 + c) + 1.0f; psh[i] = *(const GAS f32x4*)(sh2 + c); } }
            const float mean = wave_sum(s) * (1.0f / D); float ss = 0.f;
#pragma unroll
            for (int i = 0; i < 8; ++i) { v[i] = v[i] - mean; ss += (v[i][0] * v[i][0] + v[i][1] * v[i][1]) + (v[i][2] * v[i][2] + v[i][3] * v[i][3]); }
            const float rstd = rsqrtf(wave_sum(ss) * (1.0f / D) + LN_EPS);
#pragma unroll
            for (int i = 0; i < 8; ++i) { const int c = 4 * F.lane + 256 * i;
                const f32x4 lat = v[i] * rstd * *(const GAS f32x4*)(lng + c) + *(const GAS f32x4*)(lnb + c);
                { u32x2 wl; wl.x = pk2(lat[0], lat[1]); wl.y = pk2(lat[2], lat[3]); *(GAS u32x2*)(xr + c) = wl; }
                const f32x4 h = lat * psc[i] + psh[i];
                u32x2 w; w.x = pk2(h[0], h[1]); w.y = pk2(h[2], h[3]); *(GAS unsigned*)((unsigned char*)A0 + (size_t)row * D + c) = pk4_fp8(h[0], h[1], h[2], h[3]);
                *(LAS u32x2*)(hb + j * HB_LD + c) = w; } }
        __syncthreads();
        f32x4 acc[3][4];
#pragma unroll
        for (int mt = 0; mt < 3; ++mt)
#pragma unroll
            for (int nt = 0; nt < 4; ++nt) acc[mt][nt] = (f32x4){0.f, 0.f, 0.f, 0.f};
        { int arow[3];
#pragma unroll
          for (int mt = 0; mt < 3; ++mt) { const int rr = 16 * mt + fr; arow[mt] = (rr < TPB ? rr : TPB - 1) * HB_LD; }
#pragma unroll 2
          for (int kk = 0; kk < 8; ++kk) { const int k0 = F.wave * 256 + 32 * kk + 8 * fq;
              bf16x8 bh[4], bl[4], af[3];
#pragma unroll
              for (int nt = 0; nt < 4; ++nt) { bh[nt] = *(const GAS bf16x8*)(rwh + (size_t)(16 * nt + fr) * D + k0); bl[nt] = *(const GAS bf16x8*)(rwl + (size_t)(16 * nt + fr) * D + k0); }
#pragma unroll
              for (int mt = 0; mt < 3; ++mt) af[mt] = *(const LAS bf16x8*)(hb + arow[mt] + k0);
#pragma unroll
              for (int mt = 0; mt < 3; ++mt)
#pragma unroll
                  for (int nt = 0; nt < 4; ++nt) { acc[mt][nt] = __builtin_amdgcn_mfma_f32_16x16x32_bf16(af[mt], bh[nt], acc[mt][nt], 0, 0, 0);
                      acc[mt][nt] = __builtin_amdgcn_mfma_f32_16x16x32_bf16(af[mt], bl[nt], acc[mt][nt], 0, 0, 0); } } }
        __syncthreads();
#pragma unroll
        for (int mt = 0; mt < 3; ++mt)
#pragma unroll
            for (int nt = 0; nt < 4; ++nt)
#pragma unroll
                for (int j = 0; j < 4; ++j) part[(F.wave * 48 + 16 * mt + 4 * fq + j) * 64 + 16 * nt + fr] = acc[mt][nt][j];
        __syncthreads();
        for (int j = F.wave; j < TPB; j += 8) { const int row = rb + j; float logit = 0.f;
#pragma unroll
            for (int w = 0; w < 8; ++w) logit += part[(w * 48 + j) * 64 + F.lane];
            const float sg = 1.0f / (1.0f + expf(-logit)), bsd = sg + rbias;
            float m1 = bsd;
#pragma unroll
            for (int o = 1; o < 8; o <<= 1) m1 = fmaxf(m1, __shfl_xor(m1, o));
            int idx = (bsd == m1) ? (F.lane & 7) : 8;
#pragma unroll
            for (int o = 1; o < 8; o <<= 1) idx = min(idx, __shfl_xor(idx, o));
            float m2 = ((F.lane & 7) == idx) ? -INFINITY : bsd;
#pragma unroll
            for (int o = 1; o < 8; o <<= 1) m2 = fmaxf(m2, __shfl_xor(m2, o));
            const float gs = m1 + m2; const int mygrp = F.lane >> 3; int grank = 0;
#pragma unroll
            for (int gg = 0; gg < 8; ++gg) { const float og = __builtin_bit_cast(float, __builtin_amdgcn_readlane(__builtin_bit_cast(int, gs), gg * 8)); grank += (og > gs || (og == gs && gg < mygrp)) ? 1 : 0; }
            const bool gsel = grank < 4; const float cand = gsel ? bsd : -INFINITY; int rank = 0;
#pragma unroll 8
            for (int e2 = 0; e2 < 64; ++e2) { const float ov = __builtin_bit_cast(float, __builtin_amdgcn_readlane(__builtin_bit_cast(int, cand), e2)); rank += (ov > cand || (ov == cand && e2 < F.lane)) ? 1 : 0; }
            const bool sel = gsel && rank < TOPK;
            const float wsum = wave_sum(sel ? sg : 0.f);
            if (sel) { SE[row * 8 + rank] = F.lane; SW[row * 8 + rank] = sg / wsum * 2.5f; mycnt += 1; } }
        histw[F.wave * 64 + F.lane] = mycnt;
        __syncthreads();
        if (F.tid < 64) { int s = 0;
#pragma unroll
            for (int w = 0; w < 8; ++w) s += histw[w * 64 + F.tid];
            HIST[vb * 64 + F.tid] = s; }
        __syncthreads();
    }
}

__device__ __forceinline__ void phase_scatter(const Frame& F, int layer) {
    LAS int* pall = (LAS int*)F.lds;
    LAS int* plo = pall + 512;
    LAS int* st_l = plo + 512;
    LAS int* sel_l = st_l + 64;
    LAS int* misc = sel_l + 288;
    const int* HIST = (const int*)(F.ws + WS_HIST); const int* SE = (const int*)(F.ws + WS_SELE);
    int* EXPT = (int*)(F.ws + WS_EXPT); int* SLOT_TOK = (int*)(F.ws + WS_SLOTTOK); int* TOK_SLOT = (int*)(F.ws + WS_TOKSLOT);
    const int tok0 = layer ? TC : 0, TPB = layer ? 32 : 34, ntok = T0 - tok0;
    for (int vb = F.bid; vb < 256; vb += F.G) {
        int all = 0, lo = 0;
        for (int b = F.wave * 32; b < F.wave * 32 + 32; ++b) { const int h = HIST[b * 64 + F.lane]; all += h; lo += (b < vb) ? h : 0; }
        pall[F.wave * 64 + F.lane] = all; plo[F.wave * 64 + F.lane] = lo;
        const int rb = tok0 + vb * TPB;
        for (int i = F.tid; i < TPB * 8; i += NTHREADS) sel_l[i] = SE[rb * 8 + i];
        __syncthreads();
        if (F.wave == 0) { int tot = 0, base = 0;
#pragma unroll
            for (int w = 0; w < 8; ++w) { tot += pall[w * 64 + F.lane]; base += plo[w * 64 + F.lane]; }
            const int padded = (tot + 255) & ~255; int incl = padded;
#pragma unroll
            for (int o = 1; o < 64; o <<= 1) { const int t = __shfl_up(incl, o); if (F.lane >= o) incl += t; }
            const int start = incl - padded, total_pad = __shfl(incl, 63);
            st_l[F.lane] = start + base; if (F.lane == 0) misc[0] = total_pad;
            if (vb == 0) { EXPT[F.lane] = start; EXPT[128 + F.lane] = tot; if (F.lane == 0) { EXPT[64] = total_pad; EXPT[128 + 64] = ntok; }
                for (int s = tot; s < padded; ++s) SLOT_TOK[start + s] = tok0; } }
        __syncthreads();
        if (F.tid < TPB * 8) { const int e = sel_l[F.tid]; int rank = 0;
            for (int p = 0; p < F.tid; ++p) rank += (sel_l[p] == e) ? 1 : 0;
            const int slot = st_l[e] + rank, t = rb + (F.tid >> 3);
            SLOT_TOK[slot] = t; TOK_SLOT[t * 8 + (F.tid & 7)] = slot; }
        if (F.tid < TPB) SLOT_TOK[misc[0] + (rb - tok0) + F.tid] = rb + F.tid;
        __syncthreads();
    }
}

__device__ __forceinline__ void phase_combine(const Frame& F, const Args& a, int layer) {
    bf16_t* X = (bf16_t*)(F.ws + WS_X); bf16_t* A0 = (bf16_t*)(F.ws + WS_A0); const unsigned char* YS = F.ws + WS_YS;
    const int* TOK_SLOT = (const int*)(F.ws + WS_TOKSLOT); const float* SW = (const float*)(F.ws + WS_SELW); const int* EXPT = (const int*)(F.ws + WS_EXPT);
    const int tok0 = layer ? TC : 0, TPB = layer ? 32 : 34; const int start64 = EXPT[64];
    LAS float* P = (LAS float*)F.lds;
    for (int i = F.tid; i < 11 * (D / 4); i += NTHREADS) { const int t = i / (D / 4), c = 4 * (i % (D / 4)); f32x4 v;
        if (t == 0) v = *(const GAS f32x4*)(a.in[I_LNFG] + layer * D + c);
        else if (t == 1) v = *(const GAS f32x4*)(a.in[I_LNFB] + layer * D + c);
        else { const int r = (t - 2) / 3, k = (t - 2) % 3;
            if (k == 0) v = *(const GAS f32x4*)(modp(F.ws, layer, r, 5) + c);
            else if (layer == 0) { v = *(const GAS f32x4*)(modp(F.ws, 1, r, k == 1 ? 1 : 0) + c); if (k == 1) v = v + 1.0f; }
            else v = (f32x4){0.f, 0.f, 0.f, 0.f}; }
        *(LAS f32x4*)(P + t * D + c) = v; }
    __syncthreads();
    for (int vb = F.bid; vb < 256; vb += F.G) {
        for (int j = F.wave; j < TPB; j += 8) { const int row = tok0 + vb * TPB + j;
            f32x4 f[8];
            { const unsigned char* ys = YS + (size_t)(start64 + row - tok0) * D;
#pragma unroll
              for (int i = 0; i < 8; ++i) f[i] = up4_fp8(*(const GAS unsigned*)(ys + 4 * F.lane + 256 * i)) * 0.0625f; }
#pragma unroll 2
            for (int jj = 0; jj < 8; ++jj) { const int slot = TOK_SLOT[row * 8 + jj]; const float w = SW[row * 8 + jj] * 0.0625f; const unsigned char* ys = YS + (size_t)slot * D;
#pragma unroll
                for (int i = 0; i < 8; ++i) f[i] += up4_fp8(*(const GAS unsigned*)(ys + 4 * F.lane + 256 * i)) * w; }
            const int r = modrow(row); bf16_t* xr = X + (size_t)row * D; float s = 0.f;
            const LAS float* pg2 = P + (2 + 3 * r) * D;
#pragma unroll
            for (int i = 0; i < 8; ++i) { const int c = 4 * F.lane + 256 * i; const u32x2 p = *(const GAS u32x2*)(xr + c); const f32x4 xv = {bflo(p.x), bfhi(p.x), bflo(p.y), bfhi(p.y)};
                f[i] = xv * ALPHA + *(const LAS f32x4*)(pg2 + c) * f[i]; s += (f[i][0] + f[i][1]) + (f[i][2] + f[i][3]); }
            const float mean = wave_sum(s) * (1.0f / D); float ss = 0.f;
#pragma unroll
            for (int i = 0; i < 8; ++i) { f[i] = f[i] - mean; ss += (f[i][0] * f[i][0] + f[i][1] * f[i][1]) + (f[i][2] * f[i][2] + f[i][3] * f[i][3]); }
            const float rstd = rsqrtf(wave_sum(ss) * (1.0f / D) + LN_EPS);
            if (layer == 0) { const LAS float* psc = P + (3 + 3 * r) * D; const LAS float* psh = P + (4 + 3 * r) * D;
#pragma unroll
                for (int i = 0; i < 8; ++i) { const int c = 4 * F.lane + 256 * i;
                    const f32x4 lat = f[i] * rstd * *(const LAS f32x4*)(P + c) + *(const LAS f32x4*)(P + D + c);
                    { u32x2 wl; wl.x = pk2(lat[0], lat[1]); wl.y = pk2(lat[2], lat[3]); *(GAS u32x2*)(xr + c) = wl; }
                    const f32x4 h = lat * *(const LAS f32x4*)(psc + c) + *(const LAS f32x4*)(psh + c);
                    u32x2 w; w.x = pk2(h[0], h[1]); w.y = pk2(h[2], h[3]); *(GAS u32x2*)(A0 + (size_t)row * D + c) = w; } }
            else { float* o = a.out + (size_t)(row - TC) * D;
#pragma unroll
                for (int i = 0; i < 8; ++i) { const int c = 4 * F.lane + 256 * i; *(GAS f32x4*)(o + c) = f[i] * rstd * *(const LAS f32x4*)(P + c) + *(const LAS f32x4*)(P + D + c); } }
        }
    }
}

__device__ __forceinline__ void phase_attention(const Frame& F, const Args& a) {
    constexpr int ABUF = 35840;
    const bf16_t* QK = (const bf16_t*)(F.ws + WS_Z); const bf16_t* VT = (const bf16_t*)(F.ws + WS_YTL); bf16_t* O = (bf16_t*)(F.ws + WS_MIX);
    const int fr = F.lane & 15, fq = F.lane >> 4;
    const int key0 = F.tid >> 4, c16 = F.tid & 15, dim0 = F.tid >> 3, c8 = F.tid & 7;
    for (int unit = ((F.G % 8 == 0) ? (F.bid % 8) * (F.G / 8) + F.bid / 8 : F.bid); unit < 256; unit += F.G) {
        const int b = unit >> 7, h = (unit >> 5) & 3, n = unit & 31;
        const int kt_lo = (2 * n - 2) < 0 ? 0 : (2 * n - 2), kt_hi = (2 * n + 3) > 63 ? 63 : (2 * n + 3), nband = kt_hi - kt_lo + 1, ntile = nband + 4, nstep = 2 * ntile;
        u32x4 kreg[2], vreg[2];
        const bf16_t* kbase = QK + 2048 + h * 128 + 8 * c16; const bf16_t* vbase = VT + (size_t)(h * 128 + dim0) * T0 + 8 * c8;
#define ATT_LOAD(step_) do { const int ti_ = (step_) % ntile; const bool cx_ = ti_ >= nband; const int kt_ = cx_ ? (ti_ - nband) : (kt_lo + ti_); const int kr_ = cx_ ? (b * CTXL + 64 * kt_) : (TC + b * SEQ + 64 * kt_); \
            kreg[0] = *(const GAS u32x4*)(kbase + (size_t)(kr_ + key0) * 2560); kreg[1] = *(const GAS u32x4*)(kbase + (size_t)(kr_ + key0 + 32) * 2560); \
            vreg[0] = *(const GAS u32x4*)(vbase + kr_); vreg[1] = *(const GAS u32x4*)(vbase + (size_t)64 * T0 + kr_); } while (0)
#define ATT_STORE(buf_) do { LAS bf16_t* Ks_ = (LAS bf16_t*)(F.lds + (buf_) * ABUF); LAS bf16_t* Vs_ = (LAS bf16_t*)(F.lds + (buf_) * ABUF + 17408); \
            *(LAS u32x4*)(Ks_ + key0 * 136 + 8 * c16) = kreg[0]; *(LAS u32x4*)(Ks_ + (key0 + 32) * 136 + 8 * c16) = kreg[1]; \
            *(LAS u32x4*)(Vs_ + dim0 * 72 + 8 * c8) = vreg[0]; *(LAS u32x4*)(Vs_ + (dim0 + 64) * 72 + 8 * c8) = vreg[1]; } while (0)
        __syncthreads();
        ATT_LOAD(0); ATT_STORE(0);
        __syncthreads();
        bf16x8 aq[2][4]; float mrun[2], lrun[2]; f32x4 o[2][8]; int qh = 0, qpos0 = 0, qrow = 0;
        for (int step = 0; step < nstep; ++step) {
            const int ti = step % ntile, pass = step / ntile;
            if (step + 1 < nstep) ATT_LOAD(step + 1);
            if (ti == 0) {
                qh = h * 4 + 2 * pass + (F.wave >> 2); const int rows0 = (F.wave & 3) * 32; qpos0 = n * 128 + rows0; qrow = TC + b * SEQ + qpos0;
#pragma unroll
                for (int m = 0; m < 2; ++m)
#pragma unroll
                    for (int kk = 0; kk < 4; ++kk) aq[m][kk] = *(const GAS bf16x8*)(QK + (size_t)(qrow + 16 * m + fr) * 2560 + qh * 128 + 32 * kk + 8 * fq);
                const float sink = a.in[I_SINK][qh];
                mrun[0] = sink; mrun[1] = sink; lrun[0] = 1.f; lrun[1] = 1.f;
#pragma unroll
                for (int m = 0; m < 2; ++m)
#pragma unroll
                    for (int nd = 0; nd < 8; ++nd) o[m][nd] = (f32x4){0.f, 0.f, 0.f, 0.f};
            }
            const bool isctx = ti >= nband; const int kt = isctx ? (ti - nband) : (kt_lo + ti);
            const LAS bf16_t* Ks = (const LAS bf16_t*)(F.lds + (step & 1) * ABUF); const LAS bf16_t* Vs = (const LAS bf16_t*)(F.lds + (step & 1) * ABUF + 17408);
            f32x4 s[2][4];
#pragma unroll
            for (int m = 0; m < 2; ++m)
#pragma unroll
                for (int nn = 0; nn < 4; ++nn) s[m][nn] = (f32x4){0.f, 0.f, 0.f, 0.f};
#pragma unroll
            for (int kk = 0; kk < 4; ++kk)
#pragma unroll
                for (int nn = 0; nn < 4; ++nn) { const bf16x8 kf = *(const LAS bf16x8*)(Ks + (16 * nn + fr) * 136 + 32 * kk + 8 * fq);
#pragma unroll
                    for (int m = 0; m < 2; ++m) s[m][nn] = __builtin_amdgcn_mfma_f32_16x16x32_bf16(kf, aq[m][kk], s[m][nn], 0, 0, 0); }
            bf16x8 pf[2][2];
#pragma unroll
            for (int m = 0; m < 2; ++m) {
                if (!isctx) { const int qpos = qpos0 + 16 * m + fr;
#pragma unroll
                    for (int nn = 0; nn < 4; ++nn)
#pragma unroll
                        for (int j = 0; j < 4; ++j) { const int d = 64 * kt + 16 * nn + 4 * fq + j - qpos; if (d > 128 || d < -128) s[m][nn][j] = -INFINITY; } }
                float mx = s[m][0][0];
#pragma unroll
                for (int nn = 0; nn < 4; ++nn)
#pragma unroll
                    for (int j = 0; j < 4; ++j) mx = fmaxf(mx, s[m][nn][j]);
                mx = fmaxf(mx, __shfl_xor(mx, 16)); mx = fmaxf(mx, __shfl_xor(mx, 32));
                const float mnew = fmaxf(mrun[m], mx), alpha = __expf(mrun[m] - mnew); mrun[m] = mnew;
                float rs = 0.f;
#pragma unroll
                for (int nn = 0; nn < 4; ++nn)
#pragma unroll
                    for (int j = 0; j < 4; ++j) { const float p = __expf(s[m][nn][j] - mnew); s[m][nn][j] = p; rs += p; }
                rs += __shfl_xor(rs, 16); rs += __shfl_xor(rs, 32);
                lrun[m] = lrun[m] * alpha + rs;
#pragma unroll
                for (int nd = 0; nd < 8; ++nd) o[m][nd] = o[m][nd] * alpha;
#pragma unroll
                for (int ks = 0; ks < 2; ++ks) { u32x4 w; w.x = cvt_pk_bf16(s[m][2 * ks][0], s[m][2 * ks][1]); w.y = cvt_pk_bf16(s[m][2 * ks][2], s[m][2 * ks][3]);
                    w.z = cvt_pk_bf16(s[m][2 * ks + 1][0], s[m][2 * ks + 1][1]); w.w = cvt_pk_bf16(s[m][2 * ks + 1][2], s[m][2 * ks + 1][3]); pf[m][ks] = __builtin_bit_cast(bf16x8, w); }
            }
#pragma unroll
            for (int ks = 0; ks < 2; ++ks)
#pragma unroll
                for (int nd = 0; nd < 8; ++nd) { const LAS bf16_t* vp = Vs + (16 * nd + fr) * 72 + 32 * ks + 4 * fq;
                    u32x4 w; const u32x2 lo = *(const LAS u32x2*)vp, hi = *(const LAS u32x2*)(vp + 16); w.x = lo.x; w.y = lo.y; w.z = hi.x; w.w = hi.y;
                    const bf16x8 vf = __builtin_bit_cast(bf16x8, w);
#pragma unroll
                    for (int m = 0; m < 2; ++m) o[m][nd] = __builtin_amdgcn_mfma_f32_16x16x32_bf16(vf, pf[m][ks], o[m][nd], 0, 0, 0); }
            if (ti == ntile - 1) {
#pragma unroll
                for (int m = 0; m < 2; ++m) { const float inv = 1.0f / lrun[m]; bf16_t* op = O + (size_t)(qrow + 16 * m + fr) * D + qh * 128 + 4 * fq;
#pragma unroll
                    for (int nd = 0; nd < 8; ++nd) { const f32x4 v = o[m][nd] * inv; u32x2 w; w.x = cvt_pk_bf16(v[0], v[1]); w.y = cvt_pk_bf16(v[2], v[3]); *(GAS u32x2*)(op + 16 * nd) = w; } }
            }
            if (step + 1 < nstep) ATT_STORE((step + 1) & 1);
            __syncthreads();
        }
#undef ATT_LOAD
#undef ATT_STORE
    }
}

constexpr int NPHASE = 20;
__global__ void __launch_bounds__(NTHREADS, 2) mk_fwd(Args args) {
    extern __shared__ __attribute__((aligned(16))) unsigned char lds_raw[];
    Frame F; F.lds = (LAS unsigned char*)lds_raw; F.tid = threadIdx.x; F.lane = F.tid & 63; F.wave = __builtin_amdgcn_readfirstlane(F.tid >> 6); F.G = gridDim.x; F.bid = blockIdx.x; F.ws = args.ws;
    volatile LAS unsigned* MISC = (volatile LAS unsigned*)(F.lds + MISC_OFF + 1024);
    if (F.tid < 16) MISC[F.tid] = 0u;
    __syncthreads();
    unsigned* ctl = (unsigned*)(args.ws + WS_CTL);
    XcdBarrier bar; bar.bar = ctl + CW_BAR; bar.x = 0; bar.st = nullptr;
    if (!MK_PER_PHASE) bar = xcd_barrier_post(ctl + CW_BAR, MISC + 8);
    const int lo = args.ph_lo, hi = args.ph_hi;
    unsigned char* ws = args.ws;
#ifndef DUP_PHASE
#define DUP_PHASE -1
#endif
#define IN(k) (lo <= (k) && (k) < hi)
#define REP(k) for (int rep_ = 0; rep_ < ((k) == DUP_PHASE ? 2 : 1); ++rep_)
#define SEAM(k) do { if (IN(k) && IN((k) + 1)) xcd_barrier(bar); } while (0)
    LAS unsigned char* ring = F.lds;
    LAS i32x4* ut = (LAS i32x4*)(F.lds + MISC_OFF + 1152);
    constexpr int QD = 8, QD2 = 11, QG = 3, QM = 1, QS = 4;
    const int vcu = (F.G % 8 == 0) ? (F.bid % 8) * (F.G / 8) + F.bid / 8 : F.bid;

    if (IN(0)) REP(0) { conv_range(F, args, 0, cv::N3 + cv::HALFM); conv_range(F, args, cv::NG, cv::NG + cv::HALFM);
        __syncthreads(); p0_mod(F, args); p0_tables(F, args.in[I_RW]); }
    SEAM(0);
    if (IN(1)) REP(1) phase_modulate0(F, args);
    SEAM(1);
    if (IN(2)) REP(2) { DenseSched S{(const char*)(ws + WS_A0), (const char*)(ws + WS_WIN), D, D, 34, 12, F.G, F.bid}; EpiWin E{(bf16_t*)(ws + WS_Z)};
        pg8::gemm_phase<EpiWin, DenseSched>(ring, D, D, S, E); if (F.bid >= 408 - F.G) conv_pull(F, args, QD2); }
    SEAM(2);
    if (IN(3)) REP(3) { Dft1Sched S{ws, F.G, F.bid}; EpiBf16G E{(bf16_t*)(ws + WS_YTL), (bf16_t*)(ws + WS_YTC), SEQ, CTXL, 1.0f, 1.0f};
        pg8::gemm_phase<EpiBf16G, Dft1Sched>(ring, 256, 3072, S, E); __syncthreads(); phase_sgu(F, args); if (F.bid >= 2 * (272 - F.G)) conv_pull(F, args, QS); }
    SEAM(3);
    if (IN(4)) REP(4) phase_butterfly(F);
    SEAM(4);
    if (IN(5)) REP(5) { Dft2Sched S{ws, F.G, F.bid}; EpiBf16G E{(bf16_t*)(ws + WS_MIX), (bf16_t*)(ws + WS_MIX), D, D, 1.0f / 1024.0f, 1.0f / 256.0f};
        pg8::gemm_phase<EpiBf16G, Dft2Sched>(ring, 512, 512, S, E); if (F.bid >= 136) conv_pull(F, args, QS); }
    SEAM(5);
    if (IN(6)) REP(6) { const int g6 = (F.G == 256) ? 136 : F.G;
        DenseSched S{(const char*)(ws + WS_MIX), (const char*)(ws + WS_WOUT), D, D, 34, 8, g6, F.bid}; EpiResid E{(bf16_t*)(ws + WS_X), args.in[I_X], args.in[I_CTX], ws, 0, 0};
        pg8::gemm_phase<EpiResid, DenseSched>(ring, D, D, S, E);
        if (F.bid >= g6) conv_pull(F, args, 26); else if (F.G != 256 && F.bid >= 272 - F.G) conv_pull(F, args, QD); }
    SEAM(6);
    if (IN(7)) REP(7) phase_ln_router(F, args, 0);
    SEAM(7);
    if (IN(8)) REP(8) { phase_scatter(F, 0); conv_cleanup(F, args, cv::HALFM); }
    SEAM(8);
    if (IN(9)) REP(9) { moe_tables(F, 4, F.G, true); MoeSched S{ws, ut, (const int*)(ws + WS_SLOTTOK), 0}; EpiGateUp E{(bf16_t*)(ws + WS_ACT)};
        pg8::gemm_phase<EpiGateUp, MoeSched, true, true, 122>(ring, D / 2, D / 2, S, E); if (moe_conv(F)) conv_pull(F, args, 34); else if (moe_short(F)) conv_pull(F, args, QG); }
    SEAM(9);
    if (IN(10)) REP(10) { moe_tables(F, 8, F.G, true); MoeDownSched S{ws, ut, 0}; EpiYs8 E{ws + WS_YS};
        pg8::gemm_phase<EpiYs8, MoeDownSched, true, true, 122>(ring, EDIM / 2, EDIM / 2, S, E); if (moe_conv(F)) conv_pull(F, args, 20); else if (moe_short(F)) conv_pull(F, args, QM); }
    SEAM(10);
    if (IN(11)) REP(11) phase_combine(F, args, 0);
    SEAM(11);
    if (IN(12)) REP(12) { QkvSched S{ws, F.G, F.bid}; EpiQkv E{(bf16_t*)(ws + WS_Z), (bf16_t*)(ws + WS_YTL), (const f32x2*)(ws + WS_ROPE)};
        pg8::gemm_phase<EpiQkv, QkvSched>(ring, D, D, S, E); if (F.bid >= 392 - F.G) conv_pull(F, args, QD2); }
    SEAM(12);
    if (IN(13)) REP(13) phase_attention(F, args);
    SEAM(13);
    if (IN(14)) REP(14) { DenseSched S{(const char*)(ws + WS_MIX) + (size_t)TC * D * 2, (const char*)(ws + WS_WAO), D, D, 32, 8, F.G, F.bid}; EpiResid E{(bf16_t*)(ws + WS_X), nullptr, nullptr, ws, 1, TC};
        pg8::gemm_phase<EpiResid, DenseSched>(ring, D, D, S, E); }
    SEAM(14);
    if (IN(15)) REP(15) phase_ln_router(F, args, 1);
    SEAM(15);
    if (IN(16)) REP(16) { phase_scatter(F, 1); conv_cleanup(F, args, 4 * cv::HALFM); }
    SEAM(16);
    if (IN(17)) REP(17) { moe_tables(F, 4, F.G, false); MoeSched S{ws, ut, (const int*)(ws + WS_SLOTTOK), 1}; EpiGateUp E{(bf16_t*)(ws + WS_ACT)};
        pg8::gemm_phase<EpiGateUp, MoeSched, true, true, 122>(ring, D / 2, D / 2, S, E); }
    SEAM(17);
    if (IN(18)) REP(18) { moe_tables(F, 8, F.G, false); MoeDownSched S{ws, ut, 1}; EpiYs8 E{ws + WS_YS};
        pg8::gemm_phase<EpiYs8, MoeDownSched, true, true, 122>(ring, EDIM / 2, EDIM / 2, S, E); }
    SEAM(18);
    if (IN(19)) REP(19) phase_combine(F, args, 1);
#undef IN
#undef SEAM
}

extern "C" void kernel_launch(void* const* d_in, const int* in_sizes, int n_in, void* d_out, int out_size, void* d_ws, size_t ws_size, hipStream_t stream) {
    static int grid = 0;
    if (grid == 0) {
        if (n_in != 27 || out_size != TL * D || ws_size < WS_END) { fprintf(stderr, "kernel_launch: unexpected shapes (n_in %d out %d ws %zu)\n", n_in, out_size, ws_size); grid = -1; return; }
        int dev = 0, cus = 0, per_cu = 0;
        if (hipGetDevice(&dev) != hipSuccess || hipDeviceGetAttribute(&cus, hipDeviceAttributeMultiprocessorCount, dev) != hipSuccess) { grid = -1; return; }
        if (hipFuncSetAttribute((const void*)mk_fwd, hipFuncAttributeMaxDynamicSharedMemorySize, LDS_BYTES) != hipSuccess) { fprintf(stderr, "kernel_launch: hipFuncSetAttribute failed\n"); grid = -1; return; }
        if (hipOccupancyMaxActiveBlocksPerMultiprocessor(&per_cu, (const void*)mk_fwd, NTHREADS, LDS_BYTES) != hipSuccess || per_cu < 1) fprintf(stderr, "kernel_launch: occupancy query reports %d\n", per_cu);
        (void)hipGetLastError();
        grid = cus < 256 ? cus : 256;
    }
    if (grid < 0) return;
    (void)hipMemsetAsync((char*)d_ws + WS_CTL, 0, CTL_ZERO_BYTES, stream);
    Args a{};
    for (int i = 0; i < 27; ++i) a.in[i] = (const float*)d_in[i];
    a.out = (float*)d_out; a.ws = (unsigned char*)d_ws;
#if MK_PER_PHASE
    for (int p = 0; p < NPHASE; ++p) { a.ph_lo = p; a.ph_hi = p + 1; hipLaunchKernelGGL(mk_fwd, dim3(grid), dim3(NTHREADS), LDS_BYTES, stream, a); }
#else
    a.ph_lo = 0; a.ph_hi = NPHASE; hipLaunchKernelGGL(mk_fwd, dim3(grid), dim3(NTHREADS), LDS_BYTES, stream, a);
#endif
}
```
